# Optimizing an MI355X kernel written in HIP

```python
import math
import jax, jax.numpy as jnp
from jax import lax
import numpy as np

D_MODEL = 1024
BATCH = 8
SEQ = 4096
DEPTH = 1

A_HEADS = 8
A_HEAD_DIM = 64
A_WIDTH = A_HEADS * A_HEAD_DIM
MOBA_BLOCK = 256
MOBA_TOPK = 3
MOBA_Q_CHUNK = 16
REL_BUCKETS = 32
REL_MAX_DIST = 128
B_HEADS = 8
QK_NOPE = 64
QK_ROPE = 32
V_HEAD = 64
B_WIDTH = B_HEADS * V_HEAD
Q_LORA = 384
KV_LORA = 256
ROPE_THETA = 10000.0
MLA_Q_BLOCK = 128
D_FF = 4 * D_MODEL
EPS = 1e-6
NEG = -1e30
IN_SPLITS = (A_WIDTH, A_WIDTH, A_WIDTH, Q_LORA, KV_LORA, QK_ROPE, D_MODEL, D_MODEL)
IN_COLS = sum(IN_SPLITS)

kernel_name = "hybrid_moba_mla_gated_block"


def rmsnorm(x, g):
    xf = x.astype(jnp.float32)
    y = xf * lax.rsqrt(jnp.mean(xf * xf, axis=-1, keepdims=True) + EPS)
    return (y * g.astype(jnp.float32)).astype(x.dtype)


def rope(x, pos):
    half = QK_ROPE // 2
    inv_freq = ROPE_THETA ** (-jnp.arange(half, dtype=jnp.float32) / half)
    ang = pos.astype(jnp.float32)[:, None] * inv_freq[None, :]
    cos = jnp.cos(ang)[None, :, None, :]
    sin = jnp.sin(ang)[None, :, None, :]
    xf = x.astype(jnp.float32)
    x1, x2 = xf[..., :half], xf[..., half:]
    return jnp.concatenate([x1 * cos - x2 * sin, x2 * cos + x1 * sin], axis=-1).astype(x.dtype)


def t5_bucket(dist):
    dist = jnp.maximum(dist, 0)
    max_exact = REL_BUCKETS // 2
    d = jnp.maximum(dist, 1).astype(jnp.float32)
    large = max_exact + (jnp.log(d / max_exact) / math.log(REL_MAX_DIST / max_exact)
                         * (REL_BUCKETS - max_exact)).astype(jnp.int32)
    large = jnp.minimum(large, REL_BUCKETS - 1)
    return jnp.where(dist < max_exact, dist, large)


def moba_attention(q, k, v, rel_bias):
    B, S, H, D = q.shape
    scale = D ** -0.5
    nblk = -(-S // MOBA_BLOCK)
    pad = nblk * MOBA_BLOCK - S
    kb = jnp.pad(k, ((0, 0), (0, pad), (0, 0), (0, 0))).reshape(B, nblk, MOBA_BLOCK, H, D).transpose(0, 3, 1, 2, 4)
    vb = jnp.pad(v, ((0, 0), (0, pad), (0, 0), (0, 0))).reshape(B, nblk, MOBA_BLOCK, H, D).transpose(0, 3, 1, 2, 4)
    k_mean = jnp.mean(kb, axis=3)
    pos = jnp.arange(S)
    q_blk = pos // MOBA_BLOCK
    gate = jnp.einsum('bshd,bhnd->bhsn', q, k_mean).astype(jnp.float32)
    past = jnp.arange(nblk)[None, :] < q_blk[:, None]
    gate = jnp.where(past[None, None], gate, NEG)
    n_sel = min(MOBA_TOPK, nblk)
    _, sel = lax.top_k(gate, n_sel)
    sel_valid = jnp.arange(n_sel)[None, :] < q_blk[:, None]
    bias_table = rel_bias.T
    nq = S // MOBA_Q_CHUNK
    QC = MOBA_Q_CHUNK
    qs = q.reshape(B, nq, QC, H, D).swapaxes(0, 1)
    sels = sel.reshape(B, H, nq, QC, n_sel).transpose(2, 0, 1, 3, 4)
    valids = sel_valid.reshape(nq, QC, n_sel)
    bi = jnp.arange(B)[:, None, None, None]
    hi = jnp.arange(H)[None, :, None, None]
    offs = jnp.arange(MOBA_BLOCK)

    def chunk_fn(args):
        c, qc, sc, vc = args
        q_pos = c * QC + jnp.arange(QC)
        own = (c * QC) // MOBA_BLOCK
        k_own = lax.dynamic_index_in_dim(kb, own, axis=2, keepdims=False)
        v_own = lax.dynamic_index_in_dim(vb, own, axis=2, keepdims=False)
        k_g = kb[bi, hi, sc]
        v_g = vb[bi, hi, sc]
        kpos_past = sc[..., None] * MOBA_BLOCK + offs
        bias_past = bias_table[hi[..., None], t5_bucket(q_pos[:, None, None] - kpos_past)]
        logit_past = jnp.einsum('bqhd,bhqrkd->bhqrk', qc, k_g).astype(jnp.float32) * scale + bias_past
        logit_past = jnp.where(vc[None, None, :, :, None], logit_past, NEG)
        kpos_own = own * MOBA_BLOCK + offs
        bias_own = bias_table[:, t5_bucket(q_pos[:, None] - kpos_own[None, :])]
        logit_own = jnp.einsum('bqhd,bhkd->bhqk', qc, k_own).astype(jnp.float32) * scale + bias_own
        logit_own = jnp.where((kpos_own[None, :] <= q_pos[:, None])[None, None], logit_own, NEG)
        logits = jnp.concatenate([logit_past.reshape(B, H, QC, n_sel * MOBA_BLOCK), logit_own], axis=-1)
        p = jax.nn.softmax(logits, axis=-1).astype(v.dtype)
        p_past = p[..., :n_sel * MOBA_BLOCK].reshape(B, H, QC, n_sel, MOBA_BLOCK)
        p_own = p[..., n_sel * MOBA_BLOCK:]
        return (jnp.einsum('bhqrk,bhqrkd->bqhd', p_past, v_g)
                + jnp.einsum('bhqk,bhkd->bqhd', p_own, v_own))

    out = lax.map(chunk_fn, (jnp.arange(nq), qs, sels, valids))
    return out.swapaxes(0, 1).reshape(B, S, H * D)


def mla_attention(q_nope, q_rope, k_nope, k_rope, v):
    B, S, H, _ = q_nope.shape
    scale = (QK_NOPE + QK_ROPE) ** -0.5
    nqb = S // MLA_Q_BLOCK
    k_pos = jnp.arange(S)
    qn = q_nope.reshape(B, nqb, MLA_Q_BLOCK, H, QK_NOPE).swapaxes(0, 1)
    qr = q_rope.reshape(B, nqb, MLA_Q_BLOCK, H, QK_ROPE).swapaxes(0, 1)

    def block_fn(args):
        i, qn_b, qr_b = args
        q_pos = i * MLA_Q_BLOCK + jnp.arange(MLA_Q_BLOCK)
        logits = (jnp.einsum('bqhd,bkhd->bhqk', qn_b, k_nope)
                  + jnp.einsum('bqhd,bkd->bhqk', qr_b, k_rope)).astype(jnp.float32) * scale
        mask = k_pos[None, :] <= q_pos[:, None]
        logits = jnp.where(mask[None, None], logits, NEG)
        p = jax.nn.softmax(logits, axis=-1).astype(v.dtype)
        return jnp.einsum('bhqk,bkhd->bqhd', p, v)

    out = lax.map(block_fn, (jnp.arange(nqb), qn, qr))
    return out.swapaxes(0, 1).reshape(B, S, H * V_HEAD)


def setup_inputs(seed: int = 0) -> dict:
    key = jax.random.key(seed)
    ks = jax.random.split(key, 17)

    def w(k, shape, fan_in):
        return jax.random.normal(k, shape, jnp.float32) * fan_in ** -0.5

    def gain(k, shape):
        return 1.0 + 0.05 * jax.random.normal(k, shape, jnp.float32)

    L = DEPTH
    return {
        'x': jax.random.normal(ks[0], (BATCH, SEQ, D_MODEL), jnp.float32),
        'w_in': w(ks[1], (L, D_MODEL, IN_COLS), D_MODEL),
        'rel_bias': 0.5 * jax.random.normal(ks[2], (REL_BUCKETS, A_HEADS), jnp.float32),
        'mla_q_norm': gain(ks[3], (L, Q_LORA)),
        'w_uq': w(ks[4], (L, Q_LORA, B_HEADS * (QK_NOPE + QK_ROPE)), Q_LORA),
        'mla_kv_norm': gain(ks[5], (L, KV_LORA)),
        'w_uk': w(ks[6], (L, KV_LORA, B_HEADS * QK_NOPE), KV_LORA),
        'w_uv': w(ks[7], (L, KV_LORA, B_HEADS * V_HEAD), KV_LORA),
        'w_proj_a': w(ks[8], (L, A_WIDTH, D_MODEL), A_WIDTH),
        'w_proj_b': w(ks[9], (L, B_WIDTH, D_MODEL), B_WIDTH),
        'w_out': w(ks[10], (L, D_MODEL, D_MODEL), D_MODEL),
        'norm_attn': gain(ks[11], (L, D_MODEL)),
        'norm_mlp': gain(ks[12], (L, D_MODEL)),
        'w_mlp_up': w(ks[13], (L, D_MODEL, D_FF), D_MODEL),
        'w_mlp_down': w(ks[14], (L, D_FF, D_MODEL), D_FF),
        'norm_final': gain(ks[15], (D_MODEL,)),
    }


def reference(x, w_in, rel_bias, mla_q_norm, w_uq, mla_kv_norm, w_uk, w_uv, w_proj_a, w_proj_b,
              w_out, norm_attn, norm_mlp, w_mlp_up, w_mlp_down, norm_final):
    B, S, _ = x.shape
    pos = jnp.arange(S)
    split_pts = list(np.cumsum(IN_SPLITS)[:-1])
    h = x
    for l in range(DEPTH):
        n = rmsnorm(h, norm_attn[l])
        proj = n @ w_in[l]
        qa, ka, va, cq, ckv, kr, ga, gb = jnp.split(proj, split_pts, axis=-1)
        oa = moba_attention(qa.reshape(B, S, A_HEADS, A_HEAD_DIM),
                            ka.reshape(B, S, A_HEADS, A_HEAD_DIM),
                            va.reshape(B, S, A_HEADS, A_HEAD_DIM), rel_bias)
        cq = rmsnorm(cq, mla_q_norm[l])
        q = (cq @ w_uq[l]).reshape(B, S, B_HEADS, QK_NOPE + QK_ROPE)
        q_nope, q_rope = q[..., :QK_NOPE], rope(q[..., QK_NOPE:], pos)
        ckv = rmsnorm(ckv, mla_kv_norm[l])
        k_nope = (ckv @ w_uk[l]).reshape(B, S, B_HEADS, QK_NOPE)
        v_b = (ckv @ w_uv[l]).reshape(B, S, B_HEADS, V_HEAD)
        k_rope = rope(kr[:, :, None, :], pos)[:, :, 0, :]
        ob = mla_attention(q_nope, q_rope, k_nope, k_rope, v_b)
        merged = jax.nn.sigmoid(ga) * (oa @ w_proj_a[l]) + jax.nn.sigmoid(gb) * (ob @ w_proj_b[l])
        h = h + merged @ w_out[l]
        m = rmsnorm(h, norm_mlp[l])
        h = h + jnp.square(jax.nn.relu(m @ w_mlp_up[l])) @ w_mlp_down[l]
    return rmsnorm(h, norm_final)
```

```cpp
#include <hip/hip_runtime.h>
#include <hip/hip_cooperative_groups.h>
#include <hip/hip_bf16.h>
#include <cstdio>
#include <cstdint>
#include <cmath>
namespace cg = cooperative_groups;

#ifndef MK_N_LAUNCHES
#define MK_N_LAUNCHES 1
#endif

constexpr int BATCH = 8, SEQ = 4096, DM = 1024, M = BATCH * SEQ;
constexpr int AH = 8, AW = 512;
constexpr int QL = 384, KVL = 256, ROPE = 32, QKD = 96;
constexpr int FF = 4096;
constexpr int N1 = 18 * 256;
constexpr float EPS = 1e-6f;
constexpr float LOG2E = 1.4426950408889634f;
constexpr float C2A = 0.125f * LOG2E;
constexpr float C2B = 0.10206207261596577f * LOG2E;

constexpr size_t MiB = 1u << 20;
constexpr size_t WS_WIN = 2 * MiB, WS_WUQ = 11 * MiB, WS_WUKV = 12 * MiB, WS_WPA = 13 * MiB, WS_WPB = 14 * MiB, WS_WOUT = 15 * MiB, WS_WUP = 17 * MiB, WS_WDN = 25 * MiB;
constexpr size_t WS_ROPE = 33 * MiB;
constexpr size_t WS_SSQQ = 34 * MiB, WS_SSQKV = 35 * MiB;
constexpr size_t WS_KMH = 35 * MiB + 512 * 1024, WS_KML = WS_KMH + 128 * 1024;
constexpr size_t WS_HS = 36 * MiB, WS_H2S = 38 * MiB;
constexpr size_t WS_XB = 40 * MiB;
#ifdef EXP_RELOC
constexpr size_t WS_OA = 372 * MiB, WS_OB = 404 * MiB;
#else
constexpr size_t WS_OA = 40 * MiB, WS_OB = 72 * MiB;
#endif
constexpr size_t WS_QA = 104 * MiB, WS_KA = 136 * MiB, WS_VA = 168 * MiB;
constexpr size_t WS_MG = 104 * MiB;
constexpr size_t WS_HB = 168 * MiB;
constexpr size_t WS_CQ = 200 * MiB, WS_CKV = 224 * MiB, WS_KR = 240 * MiB;
constexpr size_t WS_SGA = 244 * MiB, WS_SGB = 308 * MiB;
constexpr size_t WS_QB = 372 * MiB, WS_KN = 420 * MiB, WS_VB = 452 * MiB;
constexpr size_t WS_U = 232 * MiB;
constexpr size_t WS_END = 488 * MiB;

namespace pg8 {
#define PG8_LAS __attribute__((address_space(3)))
typedef unsigned short bf16_t;
typedef short bf16x8 __attribute__((ext_vector_type(8)));
typedef float f32x4 __attribute__((ext_vector_type(4)));
typedef unsigned u32x4 __attribute__((ext_vector_type(4)));
constexpr int BM = 256, BK = 64, HALF = 128, HTB = HALF * BK * 2  , STAGE_BYTES = 8 * HTB, NXCD = 8, WGM = 8;

__host__ __device__ __forceinline__ int lds_byte(int r, int c) { const int st = (r >> 4) * 2 + (c >> 5), rr = r & 15, cc = c & 31, ob = rr * 64 + cc * 2; return st * 1024 + (ob ^ (((ob >> 9) & 1) << 5)); }
__host__ __device__ __forceinline__ void stage_rc(int b, int& R, int& C) { const int st = b / 1024, sb = b % 1024, swz = sb ^ (((sb >> 9) & 1) << 5); R = (st >> 1) * 16 + swz / 64; C = (st & 1) * 32 + (swz % 64) / 2; }
__host__ __device__ __forceinline__ int perm32(int rho) { const int n = rho >> 4, i = rho & 15; return 8 * (i >> 2) + 4 * n + (i & 3); }

struct Unit { int pm, pn; };
struct Gemm { const bf16_t* A; const bf16_t* Bt; int M, N, K; };

struct StaticOrder {
    int nM, nN, nwg, G, c;
    __host__ __device__ void init(int M, int N, int G_, int c_) { nM = M / BM; nN = N / BM; nwg = nM * nN; G = G_; c = c_; }
    __host__ __device__ bool next(int i, Unit& u) const {
        const long L = (long)i * G + c; if (L >= nwg) return false;
        int wgid = (int)L; { const int q = nwg / NXCD, r = nwg % NXCD, xcd = wgid % NXCD, off = wgid / NXCD; wgid = (xcd < r ? xcd * (q + 1) : r * (q + 1) + (xcd - r) * q) + off; }
        const int nig = WGM * nN, gid = wgid / nig, fm = gid * WGM, gsz = (nM - fm) < WGM ? (nM - fm) : WGM;
        u.pm = fm + ((wgid % nig) % gsz); u.pn = (wgid % nig) / gsz; return true;
    }
    __device__ __forceinline__ void a_ready(const Unit&) const {}
    __device__ __forceinline__ void done(const Unit&) const {}
};

__device__ __forceinline__ unsigned cvt_pk_bf16(float lo, float hi) { typedef float f2_ __attribute__((ext_vector_type(2))); typedef __bf16 b2_ __attribute__((ext_vector_type(2))); f2_ v = {lo, hi}; b2_ b = __builtin_convertvector(v, b2_); return __builtin_bit_cast(unsigned, b); }
typedef unsigned u32x2 __attribute__((ext_vector_type(2)));
__device__ __forceinline__ u32x4 pack8(f32x4 v0, f32x4 v1) { u32x4 w; w.x = cvt_pk_bf16(v0[0], v0[1]); w.y = cvt_pk_bf16(v0[2], v0[3]); w.z = cvt_pk_bf16(v1[0], v1[1]); w.w = cvt_pk_bf16(v1[2], v1[3]); return w; }
__device__ __forceinline__ u32x2 pack4(f32x4 v) { u32x2 w; w.x = cvt_pk_bf16(v[0], v[1]); w.y = cvt_pk_bf16(v[2], v[3]); return w; }
__device__ __forceinline__ float bflo(unsigned w) { return __uint_as_float(w << 16); }
__device__ __forceinline__ float bfhi(unsigned w) { return __uint_as_float(w & 0xffff0000u); }
__device__ __forceinline__ float sq4(f32x4 v) { return (v[0] * v[0] + v[1] * v[1]) + (v[2] * v[2] + v[3] * v[3]); }
__device__ __forceinline__ float red_fq(float s) { s += __shfl_xor(s, 16); s += __shfl_xor(s, 32); return s; }
__device__ __forceinline__ f32x4 sigmoid4(f32x4 v) { f32x4 o;
#pragma unroll
    for (int e = 0; e < 4; ++e) o[e] = __builtin_amdgcn_rcpf(1.0f + __builtin_amdgcn_exp2f(-1.4426950408889634f * v[e]));
    return o; }
__device__ __forceinline__ void rope_pair(f32x4& x1, f32x4& x2, const float* tab, int pos, int fq) {
    const f32x4 c = *(const f32x4*)(tab + pos * 16 + 4 * fq), s = *(const f32x4*)(tab + 65536 + pos * 16 + 4 * fq);
    const f32x4 o1 = x1 * c - x2 * s, o2 = x2 * c + x1 * s; x1 = o1; x2 = o2;
}

#define EPI_OPAQUE(fr, fq) do { int l_ = (fr) | ((fq) << 4); asm volatile("" : "+v"(l_)); (fr) = l_ & 15; (fq) = l_ >> 4; } while (0)
#define EPI_ROWS(ai, m) _Pragma("unroll") for (int ai = 0; ai < 2; ++ai) _Pragma("unroll") for (int m = 0; m < 4; ++m)

struct EpiInProj {
    static constexpr bool PERM = true, AFTER_DRAIN = false;
    unsigned char* ws;
    __device__ __forceinline__ void operator()(const f32x4 (&acc)[2][2][4][2], const Unit& u, int wr, int wc, int fr, int fq) const {
        EPI_OPAQUE(fr, fq);
        bf16_t* const QA = (bf16_t*)(ws + WS_QA); bf16_t* const KA = (bf16_t*)(ws + WS_KA); bf16_t* const VA = (bf16_t*)(ws + WS_VA); bf16_t* const CQ = (bf16_t*)(ws + WS_CQ); bf16_t* const CKV = (bf16_t*)(ws + WS_CKV);
        bf16_t* const KR = (bf16_t*)(ws + WS_KR); bf16_t* const SGA = (bf16_t*)(ws + WS_SGA); bf16_t* const SGB = (bf16_t*)(ws + WS_SGB); float* const ssq_q = (float*)(ws + WS_SSQQ); float* const ssq_kv = (float*)(ws + WS_SSQKV); const float* const rope = (const float*)(ws + WS_ROPE);
        const int pn = u.pn, row0 = u.pm * BM + wr * 64 + fr, cw = wc * 32 + 8 * fq;
        if (pn < 6) {
            bf16_t* base = (pn < 2 ? QA : pn < 4 ? KA : VA) + (pn & 1) * 256 + cw; const float sc = pn < 2 ? C2A : 1.0f;
            EPI_ROWS(ai, m) { bf16_t* rowp = base + (size_t)(row0 + ai * HALF + m * 16) * 512;
#pragma unroll
                for (int bj = 0; bj < 2; ++bj) *(u32x4*)(rowp + bj * HALF) = pack8(acc[ai][bj][m][0] * sc, acc[ai][bj][m][1] * sc); }
        } else if (pn < 8) {
            const int colt = (pn - 6) * 256;
            EPI_ROWS(ai, m) { const int row = row0 + ai * HALF + m * 16; float s = 0.f;
#pragma unroll
                for (int bj = 0; bj < 2; ++bj) { const int c = colt + bj * HALF + cw;
                    if (colt + bj * HALF < 384) { *(u32x4*)(CQ + (size_t)row * 384 + c) = pack8(acc[ai][bj][m][0], acc[ai][bj][m][1]); s += sq4(acc[ai][bj][m][0]) + sq4(acc[ai][bj][m][1]); } }
                s = red_fq(s); if (fq == 0) ssq_q[(size_t)row * 8 + (pn - 6) * 4 + wc] = s; }
        } else if (pn == 8) {
            EPI_ROWS(ai, m) { const int row = row0 + ai * HALF + m * 16; float s = 0.f;
#pragma unroll
                for (int bj = 0; bj < 2; ++bj) { *(u32x4*)(CKV + (size_t)row * 256 + bj * HALF + cw) = pack8(acc[ai][bj][m][0], acc[ai][bj][m][1]); s += sq4(acc[ai][bj][m][0]) + sq4(acc[ai][bj][m][1]); }
                s = red_fq(s); if (fq == 0) ssq_kv[(size_t)row * 4 + wc] = s; }
        } else if (pn == 9) {
            if (wc == 0) {
                EPI_ROWS(ai, m) { const int row = row0 + ai * HALF + m * 16; f32x4 x1 = acc[ai][0][m][0], x2 = acc[ai][0][m][1];
                    rope_pair(x1, x2, rope, row & (SEQ - 1), fq);
                    *(u32x2*)(KR + (size_t)row * 32 + 4 * fq) = pack4(x1); *(u32x2*)(KR + (size_t)row * 32 + 16 + 4 * fq) = pack4(x2); }
            }
        } else {
            bf16_t* base = (pn < 14 ? SGA : SGB) + ((pn - 10) & 3) * 256 + cw;
            EPI_ROWS(ai, m) { bf16_t* rowp = base + (size_t)(row0 + ai * HALF + m * 16) * 1024;
#pragma unroll
                for (int bj = 0; bj < 2; ++bj) *(u32x4*)(rowp + bj * HALF) = pack8(sigmoid4(acc[ai][bj][m][0]), sigmoid4(acc[ai][bj][m][1])); }
        }
    }
};
struct EpiQUp {
    static constexpr bool PERM = true, AFTER_DRAIN = false;
    bf16_t* QB; const float* ssq_q; const float* rope;
    __device__ __forceinline__ void operator()(const f32x4 (&acc)[2][2][4][2], const Unit& u, int wr, int wc, int fr, int fq) const {
        EPI_OPAQUE(fr, fq);
        const int row0 = u.pm * BM + wr * 64 + fr; float rs[2][4];
        EPI_ROWS(ai, m) { const int row = row0 + ai * HALF + m * 16;
            const f32x4 sa = *(const f32x4*)(ssq_q + (size_t)row * 8), sb = *(const f32x4*)(ssq_q + (size_t)row * 8 + 4);
            rs[ai][m] = C2B / sqrtf(((sa[0] + sa[1]) + (sa[2] + sa[3]) + (sb[0] + sb[1]) + (sb[2] + sb[3])) * (1.0f / 384.0f) + EPS);
            if (m == 3) asm volatile("" ::: "memory"); }
#pragma unroll
        for (int bj = 0; bj < 2; ++bj) { const int c = u.pn * BM + bj * HALF + wc * 32; const bool isrope = ((c >> 5) % 3) == 2;
            if (isrope) {
                EPI_ROWS(ai, m) { const int row = row0 + ai * HALF + m * 16; f32x4 v0 = acc[ai][bj][m][0] * rs[ai][m], v1 = acc[ai][bj][m][1] * rs[ai][m]; bf16_t* p = QB + (size_t)row * 768 + c;
                    rope_pair(v0, v1, rope, row & (SEQ - 1), fq); *(u32x2*)(p + 4 * fq) = pack4(v0); *(u32x2*)(p + 16 + 4 * fq) = pack4(v1);
                    if (m & 1) asm volatile("" ::: "memory"); }
            } else {
                EPI_ROWS(ai, m) { const int row = row0 + ai * HALF + m * 16; *(u32x4*)(QB + (size_t)row * 768 + c + 8 * fq) = pack8(acc[ai][bj][m][0] * rs[ai][m], acc[ai][bj][m][1] * rs[ai][m]); }
            }
        }
    }
};
struct EpiKVUp {
    static constexpr bool PERM = true, AFTER_DRAIN = false;
    bf16_t *KN, *VB; const float* ssq_kv;
    __device__ __forceinline__ void operator()(const f32x4 (&acc)[2][2][4][2], const Unit& u, int wr, int wc, int fr, int fq) const {
        EPI_OPAQUE(fr, fq);
        const int row0 = u.pm * BM + wr * 64 + fr; bf16_t* base = (u.pn < 2 ? KN : VB) + (u.pn & 1) * 256 + wc * 32 + 8 * fq;
        EPI_ROWS(ai, m) { const int row = row0 + ai * HALF + m * 16; const f32x4 sa = *(const f32x4*)(ssq_kv + (size_t)row * 4);
            const float rs = 1.0f / sqrtf(((sa[0] + sa[1]) + (sa[2] + sa[3])) * (1.0f / 256.0f) + EPS);
#pragma unroll
            for (int bj = 0; bj < 2; ++bj) *(u32x4*)(base + (size_t)row * 512 + bj * HALF) = pack8(acc[ai][bj][m][0] * rs, acc[ai][bj][m][1] * rs); }
    }
};
template <bool SECOND> struct EpiGate {
    static constexpr bool PERM = true, AFTER_DRAIN = false;
    bf16_t* MG; const bf16_t* SG;
    __device__ __forceinline__ void operator()(const f32x4 (&acc)[2][2][4][2], const Unit& u, int wr, int wc, int fr, int fq) const {
        EPI_OPAQUE(fr, fq);
        const int row0 = u.pm * BM + wr * 64 + fr, col0 = u.pn * BM + wc * 32 + 8 * fq;
        EPI_ROWS(ai, m) { const size_t off = (size_t)(row0 + ai * HALF + m * 16) * 1024 + col0;
#pragma unroll
            for (int bj = 0; bj < 2; ++bj) { const u32x4 g = *(const u32x4*)(SG + off + bj * HALF);
                f32x4 v0 = acc[ai][bj][m][0] * (f32x4){bflo(g.x), bfhi(g.x), bflo(g.y), bfhi(g.y)}, v1 = acc[ai][bj][m][1] * (f32x4){bflo(g.z), bfhi(g.z), bflo(g.w), bfhi(g.w)};
                if (SECOND) { const u32x4 t = *(const u32x4*)(MG + off + bj * HALF); v0 += (f32x4){bflo(t.x), bfhi(t.x), bflo(t.y), bfhi(t.y)}; v1 += (f32x4){bflo(t.z), bfhi(t.z), bflo(t.w), bfhi(t.w)}; }
                *(u32x4*)(MG + off + bj * HALF) = pack8(v0, v1); } }
    }
};
struct EpiResid {
    static constexpr bool PERM = true, AFTER_DRAIN = false;
    const float* base; float* out; bf16_t* outb; float* ss;
    __device__ __forceinline__ void operator()(const f32x4 (&acc)[2][2][4][2], const Unit& u, int wr, int wc, int fr, int fq) const {
        EPI_OPAQUE(fr, fq);
        const int row0 = u.pm * BM + wr * 64 + fr, col0 = u.pn * BM + wc * 32 + 8 * fq;
        EPI_ROWS(ai, m) { const int row = row0 + ai * HALF + m * 16; const size_t off = (size_t)row * 1024 + col0; float s = 0.f;
#pragma unroll
            for (int bj = 0; bj < 2; ++bj) { const f32x4 v0 = acc[ai][bj][m][0] + *(const f32x4*)(base + off + bj * HALF), v1 = acc[ai][bj][m][1] + *(const f32x4*)(base + off + bj * HALF + 4);
                *(f32x4*)(out + off + bj * HALF) = v0; *(f32x4*)(out + off + bj * HALF + 4) = v1; if (outb) *(u32x4*)(outb + off + bj * HALF) = pack8(v0, v1);
                s += sq4(v0) + sq4(v1); }
            s = red_fq(s); if (fq == 0) ss[(size_t)row * 16 + u.pn * 4 + wc] = s; }
    }
};
struct EpiUp {
    static constexpr bool PERM = true, AFTER_DRAIN = false;
    bf16_t* U; const float* ss;
    __device__ __forceinline__ void operator()(const f32x4 (&acc)[2][2][4][2], const Unit& u, int wr, int wc, int fr, int fq) const {
        EPI_OPAQUE(fr, fq);
        const int row0 = u.pm * BM + wr * 64 + fr, col0 = u.pn * BM + wc * 32 + 8 * fq;
        EPI_ROWS(ai, m) { const int row = row0 + ai * HALF + m * 16; const f32x4* sp = (const f32x4*)(ss + (size_t)row * 16);
            const f32x4 t = (sp[0] + sp[1]) + (sp[2] + sp[3]); const float rs = 1.0f / sqrtf(((t[0] + t[1]) + (t[2] + t[3])) * (1.0f / 1024.0f) + EPS);
#pragma unroll
            for (int bj = 0; bj < 2; ++bj) { f32x4 v0 = acc[ai][bj][m][0] * rs, v1 = acc[ai][bj][m][1] * rs;
#pragma unroll
                for (int e = 0; e < 4; ++e) { const float a = fmaxf(v0[e], 0.f), b = fmaxf(v1[e], 0.f); v0[e] = a * a; v1[e] = b * b; }
                *(u32x4*)(U + (size_t)row * FF + col0 + bj * HALF) = pack8(v0, v1); } }
    }
};
#undef EPI_ROWS
#undef EPI_OPAQUE

template <class Epi, class Sched, bool ALIGN_EPI = false, bool SP2 = false>
__device__ __forceinline__ void gemm_phase(PG8_LAS unsigned char* lds, const Gemm g, const Sched& S, const Epi& E) {
    int tid_ = threadIdx.x; asm volatile("" : "+v"(tid_));
    const int tid = tid_, wid = __builtin_amdgcn_readfirstlane(tid >> 6), lane = tid & 63, wr = wid >> 2, wc = wid & 3, fr = lane & 15, fq = lane >> 4;
    int K_ = g.K; asm volatile("" : "+s"(K_));
    const int K = K_, nt = K / BK;
    unsigned voffA[2], voffB[2];
#pragma unroll
    for (int i = 0; i < 2; ++i) { int R, C; stage_rc(tid * 16 + i * 8192, R, C); const int Rb = Epi::PERM ? ((R & ~31) + perm32(R & 31)) : R;
        voffA[i] = (unsigned)(R * K + C) * 2u; voffB[i] = (unsigned)(Rb * K + C) * 2u; }
    const size_t kstep = (size_t)(BK * 2);
    const size_t hstep = (size_t)HALF * K * 2;
    const size_t tstep = 2 * hstep;
    const unsigned ldsw = (unsigned)wid * 1024u;
    const int aoff = lds_byte(wr * 64 + fr, fq * 8), boff = lds_byte(wc * 32 + fr, fq * 8);
#define PG8_SA(b, h) (((b) * 2 + (h)) * HTB)
#define PG8_SB(b, h) ((4 + (b) * 2 + (h)) * HTB)
#define PG8_STAGE(bufoff, gbase, voff) do { _Pragma("unroll") for (int _i = 0; _i < 2; ++_i) \
        __builtin_amdgcn_global_load_lds((const unsigned*)((const char*)(gbase) + (voff)[_i]), (PG8_LAS unsigned*)(lds + (bufoff) + ldsw + _i * 8192), 16, 0, 0); } while (0)
#define PG8_LDA(dst, b, h) do { _Pragma("unroll") for (int m = 0; m < 4; ++m) _Pragma("unroll") for (int k = 0; k < 2; ++k) dst[m][k] = *(const PG8_LAS bf16x8*)(lds + PG8_SA(b, h) + aoff + m * 2048 + k * 1024); } while (0)
#define PG8_LDB(dst, b, h) do { _Pragma("unroll") for (int n = 0; n < 2; ++n) _Pragma("unroll") for (int k = 0; k < 2; ++k) dst[n][k] = *(const PG8_LAS bf16x8*)(lds + PG8_SB(b, h) + boff + n * 2048 + k * 1024); } while (0)
#define PG8_MMA(ai, bj, At, Bt) do { __builtin_amdgcn_s_setprio(1); _Pragma("unroll") for (int m = 0; m < 4; ++m) _Pragma("unroll") for (int n = 0; n < 2; ++n) _Pragma("unroll") for (int k = 0; k < 2; ++k) \
        acc[ai][bj][m][n] = __builtin_amdgcn_mfma_f32_16x16x32_bf16(Bt[n][k], At[m][k], acc[ai][bj][m][n], 0, 0, 0); __builtin_amdgcn_s_setprio(0); } while (0)
#define PG8_WAIT_V(n) asm volatile("s_waitcnt vmcnt(" #n ")" ::: "memory")
#define PG8_WAIT_L(n) asm volatile("s_waitcnt lgkmcnt(" #n ")" ::: "memory")
#define PG8_BAR __builtin_amdgcn_s_barrier()
#define PG8_SCHED __builtin_amdgcn_sched_barrier(0)
    Unit cur, nxt; int ui = 0;
    if (!S.next(0, cur)) return;
    f32x4 acc[2][2][4][2];
#pragma unroll
    for (int a = 0; a < 2; ++a)
#pragma unroll
        for (int b = 0; b < 2; ++b)
#pragma unroll
            for (int m = 0; m < 4; ++m)
#pragma unroll
                for (int n = 0; n < 2; ++n) acc[a][b][m][n] = (f32x4){0.f, 0.f, 0.f, 0.f};
    bf16x8 At[4][2], B0[2][2], B1[2][2];
    const char* cA = (const char*)g.A + (size_t)cur.pm * tstep; const char* cB = (const char*)g.Bt + (size_t)cur.pn * tstep;
    S.a_ready(cur);
    if constexpr (SP2) {
        PG8_STAGE(PG8_SB(0, 0), cB, voffB); PG8_STAGE(PG8_SB(0, 1), cB + hstep, voffB); PG8_STAGE(PG8_SA(0, 0), cA, voffA); PG8_STAGE(PG8_SA(0, 1), cA + hstep, voffA);
        if (wr == 1) PG8_BAR;
        PG8_WAIT_V(2); PG8_BAR;
        PG8_STAGE(PG8_SB(1, 0), cB + kstep, voffB); PG8_STAGE(PG8_SA(1, 0), cA + kstep, voffA); PG8_STAGE(PG8_SB(1, 1), cB + hstep + kstep, voffB);
        PG8_WAIT_V(6); PG8_BAR;
    } else {
        PG8_STAGE(PG8_SB(0, 0), cB, voffB); PG8_STAGE(PG8_SA(0, 0), cA, voffA); PG8_STAGE(PG8_SB(0, 1), cB + hstep, voffB); PG8_STAGE(PG8_SA(0, 1), cA + hstep, voffA);
        if (wr == 1) PG8_BAR;
        PG8_WAIT_V(4); PG8_BAR;
        PG8_STAGE(PG8_SB(1, 0), cB + kstep, voffB); PG8_STAGE(PG8_SA(1, 0), cA + kstep, voffA); PG8_STAGE(PG8_SB(1, 1), cB + hstep + kstep, voffB);
        PG8_WAIT_V(6); PG8_BAR;
    }
    for (;;) {
        const bool has_next = S.next(ui + 1, nxt);
        const char* nA = has_next ? (const char*)g.A + (size_t)nxt.pm * tstep : cA; const char* nB = has_next ? (const char*)g.Bt + (size_t)nxt.pn * tstep : cB;
        for (int t = 0; t < nt; t += 2) {
            const bool last = (t == nt - 2);
            const char* a1 = cA + (size_t)(t + 1) * kstep;
            const char* a2 = last ? nA : cA + (size_t)(t + 2) * kstep; const char* b2 = last ? nB : cB + (size_t)(t + 2) * kstep;
            const char* a3 = a2 + kstep; const char* b3 = b2 + kstep;
            if (last && has_next) S.a_ready(nxt);
            if constexpr (SP2) {
            PG8_LDB(B0, 0, 0); PG8_LDB(B1, 0, 1); PG8_SCHED; PG8_LDA(At, 0, 0); PG8_STAGE(PG8_SA(1, 1), a1 + hstep, voffA);
            PG8_WAIT_V(8); PG8_WAIT_L(0); PG8_BAR; PG8_MMA(0, 0, At, B0); PG8_MMA(0, 1, At, B1); PG8_BAR; PG8_SCHED;
            PG8_LDA(At, 0, 1); PG8_STAGE(PG8_SB(0, 0), b2, voffB); PG8_STAGE(PG8_SB(0, 1), b2 + hstep, voffB); PG8_STAGE(PG8_SA(0, 0), a2, voffA);
            PG8_WAIT_V(8); PG8_WAIT_L(0); PG8_BAR; PG8_MMA(1, 0, At, B0); PG8_MMA(1, 1, At, B1); PG8_BAR; PG8_SCHED;
            PG8_LDB(B0, 1, 0); PG8_LDB(B1, 1, 1); PG8_SCHED; PG8_LDA(At, 1, 0); PG8_STAGE(PG8_SA(0, 1), a2 + hstep, voffA);
            PG8_WAIT_V(8); PG8_WAIT_L(0); PG8_BAR; PG8_MMA(0, 0, At, B0); PG8_MMA(0, 1, At, B1); PG8_BAR; PG8_SCHED;
            PG8_LDA(At, 1, 1); PG8_STAGE(PG8_SB(1, 0), b3, voffB); PG8_STAGE(PG8_SB(1, 1), b3 + hstep, voffB); PG8_STAGE(PG8_SA(1, 0), a3, voffA);
            PG8_WAIT_V(8); PG8_WAIT_L(0); PG8_BAR; PG8_MMA(1, 0, At, B0); PG8_MMA(1, 1, At, B1); PG8_BAR; PG8_SCHED;
            } else {
            PG8_LDB(B0, 0, 0); PG8_SCHED; PG8_LDA(At, 0, 0); PG8_STAGE(PG8_SA(1, 1), a1 + hstep, voffA);
            PG8_WAIT_L(8); PG8_BAR; PG8_WAIT_L(0); PG8_MMA(0, 0, At, B0); PG8_BAR; PG8_SCHED;
            PG8_LDB(B1, 0, 1); PG8_STAGE(PG8_SB(0, 0), b2, voffB);
            PG8_BAR; PG8_WAIT_L(0); PG8_MMA(0, 1, At, B1); PG8_BAR;
            PG8_LDA(At, 0, 1); PG8_STAGE(PG8_SA(0, 0), a2, voffA);
            PG8_BAR; PG8_WAIT_L(0); PG8_MMA(1, 0, At, B0); PG8_BAR; PG8_SCHED;
            PG8_STAGE(PG8_SB(0, 1), b2 + hstep, voffB);
            PG8_WAIT_V(6); PG8_BAR; PG8_MMA(1, 1, At, B1); PG8_BAR;
            PG8_LDB(B0, 1, 0); PG8_SCHED; PG8_LDA(At, 1, 0); PG8_STAGE(PG8_SA(0, 1), a2 + hstep, voffA);
            PG8_WAIT_L(8); PG8_BAR; PG8_WAIT_L(0); PG8_MMA(0, 0, At, B0); PG8_BAR; PG8_SCHED;
            PG8_LDB(B1, 1, 1); PG8_STAGE(PG8_SB(1, 0), b3, voffB);
            PG8_BAR; PG8_WAIT_L(0); PG8_MMA(0, 1, At, B1); PG8_BAR;
            PG8_LDA(At, 1, 1); PG8_STAGE(PG8_SA(1, 0), a3, voffA);
            PG8_BAR; PG8_WAIT_L(0); PG8_MMA(1, 0, At, B0); PG8_BAR; PG8_SCHED;
            PG8_STAGE(PG8_SB(1, 1), b3 + hstep, voffB);
            PG8_WAIT_V(6); PG8_BAR; PG8_MMA(1, 1, At, B1); PG8_BAR;
            }
        }
        if constexpr (ALIGN_EPI) { if (wr == 0) PG8_BAR; }
        if constexpr (!Epi::AFTER_DRAIN) { E(acc, cur, wr, wc, fr, fq); S.done(cur); }
        if (!has_next) break;
#pragma unroll
        for (int a = 0; a < 2; ++a)
#pragma unroll
            for (int b = 0; b < 2; ++b)
#pragma unroll
                for (int m = 0; m < 4; ++m)
#pragma unroll
                    for (int n = 0; n < 2; ++n) acc[a][b][m][n] = (f32x4){0.f, 0.f, 0.f, 0.f};
        cur = nxt; cA = nA; cB = nB; ++ui;
        if constexpr (ALIGN_EPI) { if (wr == 1) PG8_BAR; }
    }
    PG8_WAIT_V(0);
    if constexpr (!ALIGN_EPI) { if (wr == 0) PG8_BAR; }
    PG8_BAR;
    if constexpr (Epi::AFTER_DRAIN) { E.fused(acc, cur, wr, wc, fr, fq, lds, wid, lane); S.done(cur); }
#undef PG8_SA
#undef PG8_SB
#undef PG8_STAGE
#undef PG8_LDA
#undef PG8_LDB
#undef PG8_MMA
#undef PG8_WAIT_V
#undef PG8_WAIT_L
#undef PG8_BAR
#undef PG8_SCHED
}
}
namespace att {
#define ALAS __attribute__((address_space(3)))
typedef short bf16x8 __attribute__((ext_vector_type(8)));
typedef short s16x4 __attribute__((ext_vector_type(4)));
typedef float f32x16 __attribute__((ext_vector_type(16)));
typedef float f32x4 __attribute__((ext_vector_type(4)));
typedef unsigned u32x4 __attribute__((ext_vector_type(4)));
typedef unsigned short bf16_t;
constexpr int K_SLOT = 12288, V_SLOT = 8192;
constexpr int L_K = 0, L_V = 2 * K_SLOT, L_WS = L_V + 2 * V_SLOT, L_LUT = L_WS + 2048, L_KM = L_LUT + 1024, L_OST = L_KM + 8192, L_END = L_OST + 32768;
constexpr float THR = 8.0f;
__device__ __forceinline__ int crow(int r, int hi) { return (r & 3) + 8 * (r >> 2) + 4 * hi; }
__device__ __forceinline__ unsigned cvtpk(float lo, float hi) { typedef float f2 __attribute__((ext_vector_type(2))); typedef __bf16 b2 __attribute__((ext_vector_type(2))); f2 v = {lo, hi}; b2 b = __builtin_convertvector(v, b2); return __builtin_bit_cast(unsigned, b); }
__device__ __forceinline__ float swapmax(float m) { auto rr = __builtin_amdgcn_permlane32_swap(__float_as_uint(m), __float_as_uint(m), false, false); return fmaxf(__uint_as_float(rr[0]), __uint_as_float(rr[1])); }
__device__ __forceinline__ float swapsum(float m) { auto rr = __builtin_amdgcn_permlane32_swap(__float_as_uint(m), __float_as_uint(m), false, false); return __uint_as_float(rr[0]) + __uint_as_float(rr[1]); }
typedef short v4i16_t __attribute__((ext_vector_type(4)));
__device__ __forceinline__ s16x4 vtr(const ALAS unsigned char* p) { return __builtin_bit_cast(s16x4, __builtin_amdgcn_ds_read_tr16_b64_v4i16((ALAS v4i16_t*)p)); }
__device__ __forceinline__ int t5_bucket(int d) {
    if (d < 16) return d;
    int b = 16; b += d >= 19; b += d >= 21; b += d >= 24; b += d >= 27; b += d >= 31; b += d >= 35; b += d >= 40; b += d >= 46; b += d >= 52; b += d >= 59; b += d >= 67; b += d >= 77; b += d >= 87; b += d >= 99; b += d >= 113;
    return b;
}
struct AttnArgs { const bf16_t *QA, *KA, *VA, *QB, *KN, *KR, *VB, *KMH, *KML; bf16_t *OA, *OB; const float* rel_bias; };

template <int MODE>
__device__ __forceinline__ void attn_unit(ALAS unsigned char* shm, const AttnArgs& A, int b, int h, int n) {
    constexpr int ND = MODE ? 6 : 4;
    int tid_ = threadIdx.x; asm volatile("" : "+v"(tid_));
    const int tid = tid_, lane = tid & 63, r32 = lane & 31, hi = lane >> 5; const int wid = __builtin_amdgcn_readfirstlane(tid >> 6);
    const long rowbase = (long)b * SEQ; const int q0 = n * 256, NT = 4 * (n + 1), qrel = wid * 32 + r32;
    ALAS float* wsf = (ALAS float*)(shm + L_WS) + wid * 64;
    ALAS float* lut = (ALAS float*)(shm + L_LUT);
    ALAS unsigned char* ost = shm + L_OST + wid * 4096;
    const bf16_t* Kg = (MODE ? A.KN : A.KA) + (size_t)lane * 512 + h * 64 + wid * 8;
    const bf16_t* Kr = A.KR + (size_t)lane * 32 + (wid & 3) * 8;
    const bf16_t* Vg = (MODE ? A.VB : A.VA) + (size_t)(16 * (wid & 3) + (lane >> 2)) * 512 + h * 64 + (wid >> 2) * 32 + (lane & 3) * 8;
    u32x4 kreg0, kreg1 = (u32x4){0u, 0u, 0u, 0u}, vreg;
#define TILE_ROW(i) (MODE ? (rowbase + 64 * (i)) : (rowbase + 256 * (((i) < 4) ? n : n - ((i) >> 2)) + 64 * ((i) & 3)))
#define ISSUE(i) do { const long r0_ = TILE_ROW(i); kreg0 = *(const u32x4*)(Kg + r0_ * 512); if (MODE && wid < 4) kreg1 = *(const u32x4*)(Kr + r0_ * 32); vreg = *(const u32x4*)(Vg + r0_ * 512); } while (0)
#define WRITE(slot) do { *(ALAS u32x4*)(shm + L_K + (slot) * K_SLOT + wid * 1024 + lane * 16) = kreg0; if (MODE && wid < 4) *(ALAS u32x4*)(shm + L_K + (slot) * K_SLOT + (8 + wid) * 1024 + lane * 16) = kreg1; \
        *(ALAS u32x4*)(shm + L_V + (slot) * V_SLOT + wid * 1024 + lane * 16) = vreg; } while (0)
    ISSUE(0);
    bf16x8 qr[ND];
    { const bf16_t* Qw = MODE ? (A.QB + (size_t)(rowbase + q0 + qrel) * 768 + h * 96) : (A.QA + (size_t)(rowbase + q0 + qrel) * 512 + h * 64);
#pragma unroll
      for (int d0 = 0; d0 < ND; ++d0) qr[d0] = *(const bf16x8*)(Qw + d0 * 16 + hi * 8); }
    unsigned selmask = 0u; float c31 = 0.f;
    if (MODE == 0) {
        if (tid < 128) lut[tid] = A.rel_bias[t5_bucket(tid) * 8 + h] * LOG2E;
        { const int t2 = tid & 255, which = t2 >> 7, c = (t2 >> 4) & 7, blk = t2 & 15; u32x4 v = (u32x4){0u, 0u, 0u, 0u};
          if (tid < 256) v = *(const u32x4*)((which ? A.KML : A.KMH) + ((size_t)(b * 8 + h) * 16 + blk) * 64 + c * 8);
          *(ALAS u32x4*)(shm + L_KM + which * 4096 + c * 512 + ((tid < 256) ? blk : 16 + blk) * 16) = v; }
    }
    WRITE(0);
    __syncthreads();
    if (MODE == 0) {
        c31 = lut[127];
        if (n > 0) {
            f32x16 g = {};
#pragma unroll
            for (int d0 = 0; d0 < 4; ++d0) {
                const bf16x8 ah = *(const ALAS bf16x8*)(shm + L_KM + (2 * d0 + hi) * 512 + r32 * 16), al = *(const ALAS bf16x8*)(shm + L_KM + 4096 + (2 * d0 + hi) * 512 + r32 * 16);
                g = __builtin_amdgcn_mfma_f32_32x32x16_bf16(ah, qr[d0], g, 0, 0, 0); g = __builtin_amdgcn_mfma_f32_32x32x16_bf16(al, qr[d0], g, 0, 0, 0); }
            ALAS float* gs = (ALAS float*)ost;
            *(ALAS f32x4*)(gs + r32 * 16 + 4 * hi) = (f32x4){g[0], g[1], g[2], g[3]}; *(ALAS f32x4*)(gs + r32 * 16 + 8 + 4 * hi) = (f32x4){g[4], g[5], g[6], g[7]};
            asm volatile("s_waitcnt lgkmcnt(0)" ::: "memory");
            float gg[16];
#pragma unroll
            for (int j4 = 0; j4 < 4; ++j4) { const f32x4 t = *(const ALAS f32x4*)(gs + r32 * 16 + 4 * j4); gg[4 * j4] = t[0]; gg[4 * j4 + 1] = t[1]; gg[4 * j4 + 2] = t[2]; gg[4 * j4 + 3] = t[3]; }
            asm volatile("s_waitcnt lgkmcnt(0)" ::: "memory");
#pragma unroll
            for (int k = 0; k < 3; ++k) { float best = -INFINITY; int bi = -1;
#pragma unroll
                for (int j = 0; j < 16; ++j) { const bool ok = (j < n) && !((selmask >> j) & 1u) && (gg[j] > best); best = ok ? gg[j] : best; bi = ok ? j : bi; }
                if (bi >= 0) selmask |= 1u << bi; }
        }
    }
#ifdef EXP_ALLSEL
    selmask = 0xffffu;
#endif
    float mhat = 0.f, l_reg = 0.f, badd = 0.f; f32x16 o[2]; o[0] = f32x16{}; o[1] = f32x16{}; f32x16 cin = f32x16{};
    const ALAS unsigned char* kp0 = shm + L_K + hi * 1024 + r32 * 16;
    const ALAS unsigned char* vp0 = shm + L_V + ((lane >> 4) & 1) * 32 + (lane & 3) * 8 + (4 * hi + ((lane & 15) >> 2)) * 64;
    for (int i = 0; i < NT; ++i) {
        if (i + 1 < NT) ISSUE(i + 1);
        const int slot = i & 1;
        const int kb = MODE ? 0 : (i >> 2), t4 = i & 3;
        const int jb = MODE ? (i - (NT - 4)) : (kb == 0 ? t4 : -1);
        const bool active = !(jb >= 0 && 64 * jb > 32 * wid + 31);
        if (active) {
            if (MODE == 0 && t4 == 0 && i > 0) {
                const int blk = n - kb; const bool sel = (selmask >> blk) & 1u;
                badd = sel ? (kb >= 2 ? c31 : 0.f) : -INFINITY; const float cv = badd - mhat;
#pragma unroll
                for (int r = 0; r < 16; ++r) cin[r] = cv;
            }
            f32x16 p0, p1;
            { const ALAS unsigned char* kp = kp0 + slot * K_SLOT;
#pragma unroll
              for (int d0 = 0; d0 < ND; ++d0) { const bf16x8 k0 = *(const ALAS bf16x8*)(kp + d0 * 2048), k1 = *(const ALAS bf16x8*)(kp + d0 * 2048 + 512);
                  if (d0 == 0) { p0 = __builtin_amdgcn_mfma_f32_32x32x16_bf16(k0, qr[0], cin, 0, 0, 0); p1 = __builtin_amdgcn_mfma_f32_32x32x16_bf16(k1, qr[0], cin, 0, 0, 0); }
                  else { p0 = __builtin_amdgcn_mfma_f32_32x32x16_bf16(k0, qr[d0], p0, 0, 0, 0); p1 = __builtin_amdgcn_mfma_f32_32x32x16_bf16(k1, qr[d0], p1, 0, 0, 0); } } }
            if (MODE == 1) {
                if (jb >= 0) { const int kb0 = 64 * jb + 4 * hi;
#pragma unroll
                    for (int r = 0; r < 16; ++r) { const int kv = kb0 + (r & 3) + 8 * (r >> 2); if (kv > qrel) p0[r] = -INFINITY; if (kv + 32 > qrel) p1[r] = -INFINITY; } }
            } else if (kb == 0) {
                const int d0_ = qrel - (64 * t4 + 4 * hi);
#pragma unroll
                for (int r = 0; r < 16; ++r) { const int da = d0_ - ((r & 3) + 8 * (r >> 2)), db = da - 32;
                    p0[r] = da < 0 ? -INFINITY : p0[r] + lut[da > 127 ? 127 : (da < 0 ? 0 : da)]; p1[r] = db < 0 ? -INFINITY : p1[r] + lut[db > 127 ? 127 : (db < 0 ? 0 : db)]; }
            } else if (kb == 1) {
                if (64 * t4 <= 32 * wid + 80) {
#pragma unroll
                    for (int r = 0; r < 16; ++r) { p0[r] += c31; p1[r] += c31; }
                } else { const int d0_ = qrel + 256 - (64 * t4 + 4 * hi);
#pragma unroll
                    for (int r = 0; r < 16; ++r) { const int da = d0_ - ((r & 3) + 8 * (r >> 2)), db = da - 32; p0[r] += lut[da > 127 ? 127 : da]; p1[r] += lut[db > 127 ? 127 : db]; } }
            }
            float rm = fmaxf(p0[0], p1[0]);
#pragma unroll
            for (int r = 1; r < 16; ++r) rm = fmaxf(rm, fmaxf(p0[r], p1[r]));
            rm = swapmax(rm);
            if (i == 0) {
                const float dl = rm; mhat = dl;
#pragma unroll
                for (int r = 0; r < 16; ++r) { p0[r] -= dl; p1[r] -= dl; cin[r] = badd - mhat; }
            } else if (__any(rm > THR)) {
                const float dl = fmaxf(rm, 0.f); mhat += dl; const float f = __builtin_amdgcn_exp2f(-dl); l_reg *= f;
#pragma unroll
                for (int r = 0; r < 16; ++r) { p0[r] -= dl; p1[r] -= dl; cin[r] = badd - mhat; }
                if (hi == 0) wsf[r32] = f;
                asm volatile("s_waitcnt lgkmcnt(0)" ::: "memory");
#pragma unroll
                for (int r = 0; r < 16; ++r) { const float fr_ = wsf[crow(r, hi)]; o[0][r] *= fr_; o[1][r] *= fr_; }
            }
            float sacc = 0.f;
#pragma unroll
            for (int r = 0; r < 16; ++r) { p0[r] = __builtin_amdgcn_exp2f(p0[r]); p1[r] = __builtin_amdgcn_exp2f(p1[r]); sacc += p0[r] + p1[r]; }
            l_reg += sacc;
            u32x4 pw[4];
#pragma unroll
            for (int e = 0; e < 4; ++e) { pw[0][e] = cvtpk(p0[2 * e], p0[2 * e + 1]); pw[1][e] = cvtpk(p0[8 + 2 * e], p0[9 + 2 * e]); pw[2][e] = cvtpk(p1[2 * e], p1[2 * e + 1]); pw[3][e] = cvtpk(p1[8 + 2 * e], p1[9 + 2 * e]); }
            { const ALAS unsigned char* vp = vp0 + slot * V_SLOT;
#pragma unroll
              for (int d0 = 0; d0 < 2; ++d0)
#pragma unroll
                for (int ks = 0; ks < 4; ++ks) { const s16x4 lo = vtr(vp + d0 * 4096 + ks * 1024), hh = vtr(vp + d0 * 4096 + ks * 1024 + 512);
                    const bf16x8 vf = (bf16x8){lo[0], lo[1], lo[2], lo[3], hh[0], hh[1], hh[2], hh[3]};
                    o[d0] = __builtin_amdgcn_mfma_f32_32x32x16_bf16(__builtin_bit_cast(bf16x8, pw[ks]), vf, o[d0], 0, 0, 0); } }
        }
        if (i + 1 < NT) WRITE((i + 1) & 1);
        __syncthreads();
    }
    l_reg = swapsum(l_reg);
    if (hi == 0) wsf[32 + r32] = l_reg;
    asm volatile("s_waitcnt lgkmcnt(0)" ::: "memory");
    { ALAS bf16_t* stg = (ALAS bf16_t*)ost;
#pragma unroll
      for (int r = 0; r < 16; ++r) { const int orow = crow(r, hi); const float rl = __builtin_amdgcn_rcpf(wsf[32 + orow]);
#pragma unroll
          for (int d0 = 0; d0 < 2; ++d0) stg[orow * 64 + d0 * 32 + r32] = (bf16_t)(cvtpk(o[d0][r] * rl, 0.f) & 0xffffu); }
      asm volatile("s_waitcnt lgkmcnt(0)" ::: "memory");
      bf16_t* Ow = (MODE ? A.OB : A.OA) + (size_t)(rowbase + q0 + wid * 32) * 512 + h * 64;
#pragma unroll
      for (int i2 = 0; i2 < 4; ++i2) { const int row = i2 * 8 + (lane >> 3), ch = lane & 7; const u32x4 v = *(const ALAS u32x4*)(stg + row * 64 + ch * 8); *(u32x4*)(Ow + (size_t)row * 512 + ch * 8) = v; } }
    __syncthreads();
#undef TILE_ROW
#undef ISSUE
#undef WRITE
}
}

constexpr int NWAVES = 8;
constexpr int N_PHASES = 9;
constexpr int RING_BYTES = 131072;
constexpr int LDS_BYTES = 147456;
static_assert(att::L_END <= RING_BYTES, "attention scratch inside the ring region");

#define GAS __attribute__((address_space(1)))
#define LAS __attribute__((address_space(3)))
typedef unsigned short bf16;
typedef unsigned v4u __attribute__((ext_vector_type(4)));
typedef float f32x4 __attribute__((ext_vector_type(4)));
#define LDS_WAIT() asm volatile("s_waitcnt lgkmcnt(0)" ::: "memory")
__device__ __forceinline__ unsigned f2bf(float f) { unsigned u = __builtin_bit_cast(unsigned, f); return (u + 0x7fffu + ((u >> 16) & 1u)) >> 16; }
__device__ __forceinline__ unsigned pk2(float lo, float hi) { return f2bf(lo) | (f2bf(hi) << 16); }
__device__ __forceinline__ float wave_sum(float v) {
#pragma unroll
    for (int o = 1; o < 64; o <<= 1) v += __shfl_xor(v, o);
    return v;
}
__device__ __forceinline__ void p0_item(const float* W, int K, int Ns, bf16* WT, int gd, int gs, bool rope, const float* gain, LAS float* scr, int kb, int lane) {
    const int k0 = 64 * kb, c = lane & 7;
    if (gs < 0) {
#pragma unroll
        for (int j = 0; j < 4; ++j) { const int n = (lane >> 3) + 8 * j; *(v4u*)(WT + (size_t)(32 * gd + n) * K + k0 + 8 * c) = (v4u){0u, 0u, 0u, 0u}; }
        return;
    }
#pragma unroll 8
    for (int i = 0; i < 32; ++i) { const int kk = 2 * i + (lane >> 5); const float g = gain ? gain[k0 + kk] : 1.0f; scr[kk * 33 + (lane & 31)] = W[(size_t)(k0 + kk) * Ns + 32 * gs + (lane & 31)] * g; }
    LDS_WAIT(); asm volatile("" ::: "memory");
#pragma unroll
    for (int j = 0; j < 4; ++j) { const int n = (lane >> 3) + 8 * j; const int ns = rope ? (4 * (n >> 3) + (n & 3) + 16 * ((n >> 2) & 1)) : n; const LAS float* s = scr + (8 * c) * 33 + ns;
        v4u o; o.x = pk2(s[0 * 33], s[1 * 33]); o.y = pk2(s[2 * 33], s[3 * 33]); o.z = pk2(s[4 * 33], s[5 * 33]); o.w = pk2(s[6 * 33], s[7 * 33]);
        *(v4u*)(WT + (size_t)(32 * gd + n) * K + k0 + 8 * c) = o; }
    LDS_WAIT(); asm volatile("" ::: "memory");
}

struct Args { const float* in[16]; float* out; unsigned char* ws; int ph_lo, ph_hi; };
enum { I_X = 0, I_WIN, I_RELB, I_QNORM, I_WUQ, I_KVNORM, I_WUK, I_WUV, I_WPA, I_WPB, I_WOUT, I_NATTN, I_NMLP, I_WUP, I_WDN, I_NFIN };

__global__ void __launch_bounds__(NWAVES * 64, 2) mk_fwd(Args args) {
    extern __shared__ __attribute__((aligned(16))) unsigned char lds_raw[];
    LAS unsigned char* lds = (LAS unsigned char*)lds_raw;
    const int tid = threadIdx.x, lane = tid & 63, wave = __builtin_amdgcn_readfirstlane(tid >> 6);
    const int G = gridDim.x, bx = blockIdx.x, vcu = (G % 8 == 0) ? (bx % 8) * (G / 8) + bx / 8 : bx;
    unsigned char* ws = args.ws;
    const int lo = args.ph_lo, hi = args.ph_hi;
    cg::grid_group grid = cg::this_grid();
#ifndef PH_MASK
#define PH_MASK 0x1ff
#endif
#define IN(k) (((PH_MASK >> (k)) & 1) && lo <= (k) && (k) < hi)
#define SEAM(k) do { if (IN(k) && IN((k) + 1)) grid.sync(); } while (0)
    bf16* Win_t = (bf16*)(ws + WS_WIN); bf16* Wuq_t = (bf16*)(ws + WS_WUQ); bf16* Wukv_t = (bf16*)(ws + WS_WUKV); bf16* Wpa_t = (bf16*)(ws + WS_WPA); bf16* Wpb_t = (bf16*)(ws + WS_WPB);
    bf16* Wout_t = (bf16*)(ws + WS_WOUT); bf16* Wup_t = (bf16*)(ws + WS_WUP); bf16* Wdn_t = (bf16*)(ws + WS_WDN);
    float* ropetab = (float*)(ws + WS_ROPE); float* ssq_q = (float*)(ws + WS_SSQQ); float* ssq_kv = (float*)(ws + WS_SSQKV); float* hs = (float*)(ws + WS_HS); float* h2s = (float*)(ws + WS_H2S);
    bf16* KMH = (bf16*)(ws + WS_KMH); bf16* KML = (bf16*)(ws + WS_KML);
    bf16* XB = (bf16*)(ws + WS_XB); bf16* OA = (bf16*)(ws + WS_OA); bf16* OB = (bf16*)(ws + WS_OB); bf16* QA = (bf16*)(ws + WS_QA); bf16* KA = (bf16*)(ws + WS_KA); bf16* VA = (bf16*)(ws + WS_VA);
    bf16* MG = (bf16*)(ws + WS_MG); bf16* HB = (bf16*)(ws + WS_HB); bf16* CQ = (bf16*)(ws + WS_CQ); bf16* CKV = (bf16*)(ws + WS_CKV); bf16* KR = (bf16*)(ws + WS_KR);
    bf16* SGA = (bf16*)(ws + WS_SGA); bf16* SGB = (bf16*)(ws + WS_SGB); bf16* QB = (bf16*)(ws + WS_QB); bf16* KN = (bf16*)(ws + WS_KN); bf16* VB = (bf16*)(ws + WS_VB); bf16* U = (bf16*)(ws + WS_U);
    const int gw = vcu * NWAVES + wave, NGW = G * NWAVES;
#ifdef EXP_FENCE
    __builtin_amdgcn_fence(__ATOMIC_ACQUIRE, "agent"); asm volatile("s_waitcnt vmcnt(0)" ::: "memory"); __syncthreads();
#endif

    if (IN(0)) {
        LAS float* scr = (LAS float*)(lds + wave * 16384);
        constexpr int G_IN = N1 / 32, I_IN = (DM / 64) * G_IN;
        constexpr int I_UQ = (QL / 64) * 24, I_UK = (KVL / 64) * 16, I_UV = I_UK, I_PA = (AW / 64) * 32, I_PB = I_PA, I_OUT = (DM / 64) * 32, I_UP = (DM / 64) * 128, I_DN = (FF / 64) * 32;
        constexpr int NITEMS = I_IN + I_UQ + I_UK + I_UV + I_PA + I_PB + I_OUT + I_UP + I_DN;
        for (int it = gw; it < NITEMS; it += NGW) {
            int r = it;
            if (r < I_IN) { const int kb = r / G_IN, gd = r % G_IN; int gs; bool rp = false;
                if (gd < 60) gs = gd; else if (gd < 64) gs = -1; else if (gd < 72) gs = gd - 4; else if (gd == 72) { gs = 68; rp = true; } else if (gd < 80) gs = -1; else gs = gd - 11;
                p0_item(args.in[I_WIN], DM, 4256, Win_t, gd, gs, rp, args.in[I_NATTN], scr, kb, lane); continue; } r -= I_IN;
            if (r < I_UQ) { const int kb = r / 24, gd = r % 24; p0_item(args.in[I_WUQ], QL, 768, Wuq_t, gd, gd, (gd % 3) == 2, args.in[I_QNORM], scr, kb, lane); continue; } r -= I_UQ;
            if (r < I_UK) { const int kb = r / 16, gd = r % 16; p0_item(args.in[I_WUK], KVL, 512, Wukv_t, gd, gd, false, args.in[I_KVNORM], scr, kb, lane); continue; } r -= I_UK;
            if (r < I_UV) { const int kb = r / 16, gd = r % 16; p0_item(args.in[I_WUV], KVL, 512, Wukv_t, 16 + gd, gd, false, args.in[I_KVNORM], scr, kb, lane); continue; } r -= I_UV;
            if (r < I_PA) { const int kb = r / 32, gd = r % 32; p0_item(args.in[I_WPA], AW, 1024, Wpa_t, gd, gd, false, nullptr, scr, kb, lane); continue; } r -= I_PA;
            if (r < I_PB) { const int kb = r / 32, gd = r % 32; p0_item(args.in[I_WPB], AW, 1024, Wpb_t, gd, gd, false, nullptr, scr, kb, lane); continue; } r -= I_PB;
            if (r < I_OUT) { const int kb = r / 32, gd = r % 32; p0_item(args.in[I_WOUT], DM, 1024, Wout_t, gd, gd, false, nullptr, scr, kb, lane); continue; } r -= I_OUT;
            if (r < I_UP) { const int kb = r / 128, gd = r % 128; p0_item(args.in[I_WUP], DM, FF, Wup_t, gd, gd, false, args.in[I_NMLP], scr, kb, lane); continue; } r -= I_UP;
            { const int kb = r / 32, gd = r % 32; p0_item(args.in[I_WDN], FF, 1024, Wdn_t, gd, gd, false, nullptr, scr, kb, lane); }
        }
        for (int idx = gw * 64 + lane; idx < SEQ * 16; idx += NGW * 64) { const int pos = idx >> 4, i = idx & 15;
            const float inv = powf(10000.0f, -(float)i / 16.0f), ang = (float)pos * inv; float s, c; sincosf(ang, &s, &c); ropetab[idx] = c; ropetab[65536 + idx] = s; }
        for (int m = gw; m < M; m += NGW) {
            const f32x4* xr = (const f32x4*)(args.in[I_X] + (size_t)m * DM) + lane; f32x4 v[4]; float s = 0.f;
#pragma unroll
            for (int j = 0; j < 4; ++j) { v[j] = xr[64 * j]; s += (v[j].x * v[j].x + v[j].y * v[j].y) + (v[j].z * v[j].z + v[j].w * v[j].w); }
            const float rstd = 1.0f / sqrtf(wave_sum(s) * (1.0f / DM) + EPS);
            unsigned long long* o8 = (unsigned long long*)(XB + (size_t)m * DM) + lane;
#pragma unroll
            for (int j = 0; j < 4; ++j) o8[64 * j] = (unsigned long long)pk2(v[j].x * rstd, v[j].y * rstd) | ((unsigned long long)pk2(v[j].z * rstd, v[j].w * rstd) << 32);
        }
    }
    SEAM(0);
    if (IN(1)) {
        pg8::Gemm g{XB, Win_t, M, N1, DM}; pg8::StaticOrder S; S.init(M, N1, G, bx);
        pg8::EpiInProj E{ws};
        pg8::gemm_phase<pg8::EpiInProj, pg8::StaticOrder, true, true>(lds, g, S, E);
    }
    SEAM(1);
    if (IN(2)) {
        for (int it = gw; it < BATCH * 16 * AH; it += NGW) { const int h = it & 7, blk = (it >> 3) & 15, b = it >> 7;
            const bf16* src = KA + ((size_t)b * SEQ + blk * 256) * 512 + h * 64 + lane; float a0 = 0.f, a1 = 0.f, a2 = 0.f, a3 = 0.f;
#pragma unroll 4
            for (int r = 0; r < 256; r += 4) { a0 += __uint_as_float((unsigned)src[(size_t)r * 512] << 16); a1 += __uint_as_float((unsigned)src[(size_t)(r + 1) * 512] << 16);
                a2 += __uint_as_float((unsigned)src[(size_t)(r + 2) * 512] << 16); a3 += __uint_as_float((unsigned)src[(size_t)(r + 3) * 512] << 16); }
            const float mean = ((a0 + a1) + (a2 + a3)) * (1.0f / 256.0f); const unsigned hb = f2bf(mean); const float rem = mean - __uint_as_float(hb << 16);
            const size_t o = ((size_t)(b * 8 + h) * 16 + blk) * 64 + lane; KMH[o] = (bf16)hb; KML[o] = (bf16)f2bf(rem); }
#ifndef NO_P2A
        { pg8::Gemm g{CQ, Wuq_t, M, 768, QL}; pg8::StaticOrder S; S.init(M, 768, G, bx); pg8::EpiQUp E{QB, ssq_q, ropetab};
          pg8::gemm_phase<pg8::EpiQUp, pg8::StaticOrder, true, true>(lds, g, S, E); }
#endif
#ifndef NO_P2B
        { pg8::Gemm g{CKV, Wukv_t, M, 1024, KVL}; pg8::StaticOrder S; S.init(M, 1024, G, bx); pg8::EpiKVUp E{KN, VB, ssq_kv};
          pg8::gemm_phase<pg8::EpiKVUp, pg8::StaticOrder, true, true>(lds, g, S, E); }
#endif
    }
    SEAM(2);
    if (IN(3)) {
        const att::AttnArgs A{QA, KA, VA, QB, KN, KR, VB, KMH, KML, OA, OB, args.in[I_RELB]};
#ifdef EXP_COPY
        for (size_t i = (size_t)bx * 512 + tid; i < (size_t)M * 512 / 8; i += (size_t)G * 512) { ((v4u*)OA)[i] = ((const v4u*)VA)[i]; ((v4u*)OB)[i] = ((const v4u*)EXP_OBSRC)[i]; }
        if (0)
#endif
        for (int v = vcu; v < 256; v += G) { const int bh = v >> 2, s = v & 3, b = bh >> 3, h = bh & 7;
            for (int i = 0; i < 4; ++i) { const int n = (i == 0) ? 15 - s : (i == 1) ? 11 - s : (i == 2) ? 4 + s : s;
#ifndef EXP_NO_MLA
                att::attn_unit<1>(lds, A, b, h, n);
#endif
#ifndef EXP_NO_MOBA
                att::attn_unit<0>(lds, A, b, h, n);
#endif
            } }
    }
    SEAM(3);
    if (IN(4)) {
        { pg8::Gemm g{OA, Wpa_t, M, DM, AW}; pg8::StaticOrder S; S.init(M, DM, G, bx); pg8::EpiGate<false> E{MG, SGA}; pg8::gemm_phase<pg8::EpiGate<false>, pg8::StaticOrder, true, true>(lds, g, S, E); }
#ifndef EXP_P4_PASS1_ONLY
        { pg8::Gemm g{OB, Wpb_t, M, DM, AW}; pg8::StaticOrder S; S.init(M, DM, G, bx); pg8::EpiGate<true> E{MG, SGB}; pg8::gemm_phase<pg8::EpiGate<true>, pg8::StaticOrder, true, true>(lds, g, S, E); }
#endif
    }
    SEAM(4);
    if (IN(5)) {
        pg8::Gemm g{MG, Wout_t, M, DM, DM}; pg8::StaticOrder S; S.init(M, DM, G, bx); pg8::EpiResid E{args.in[I_X], args.out, HB, hs};
        pg8::gemm_phase<pg8::EpiResid, pg8::StaticOrder, true, true>(lds, g, S, E);
    }
    SEAM(5);
    if (IN(6)) {
        pg8::Gemm g{HB, Wup_t, M, FF, DM}; pg8::StaticOrder S; S.init(M, FF, G, bx); pg8::EpiUp E{U, hs};
        pg8::gemm_phase<pg8::EpiUp, pg8::StaticOrder, true, true>(lds, g, S, E);
    }
    SEAM(6);
    if (IN(7)) {
        pg8::Gemm g{U, Wdn_t, M, DM, FF}; pg8::StaticOrder S; S.init(M, DM, G, bx); pg8::EpiResid E{args.out, args.out, nullptr, h2s};
        pg8::gemm_phase<pg8::EpiResid, pg8::StaticOrder, true, true>(lds, g, S, E);
    }
    SEAM(7);
#ifdef EXP_DUMP_FULL
    if (IN(8)) { for (size_t i = (size_t)bx * 512 + tid; i < (size_t)M * 1024; i += (size_t)G * 512) args.out[i] = __uint_as_float((unsigned)EXP_DUMP_FULL[i] << 16); }
    if (0) {
#elif defined(EXP_DUMP1)
    if (IN(8)) {
        for (size_t i = (size_t)bx * 512 + tid; i < (size_t)M * 512; i += (size_t)G * 512) { const size_t row = i >> 9, c = i & 511;
            args.out[row * 1024 + c] = __uint_as_float((unsigned)EXP_DUMP_A[i] << 16); args.out[row * 1024 + 512 + c] = __uint_as_float((unsigned)EXP_DUMP_B[i] << 16); }
    }
    if (0) {
#else
    if (IN(8)) {
#endif
        const f32x4* gf = (const f32x4*)args.in[I_NFIN] + lane; f32x4 gv[4];
#pragma unroll
        for (int j = 0; j < 4; ++j) gv[j] = gf[64 * j];
        for (int m = gw; m < M; m += NGW) {
            const f32x4* sp = (const f32x4*)(h2s + (size_t)m * 16); const f32x4 t = (sp[0] + sp[1]) + (sp[2] + sp[3]);
            const float rstd = 1.0f / sqrtf(((t[0] + t[1]) + (t[2] + t[3])) * (1.0f / DM) + EPS);
            f32x4* xr = (f32x4*)(args.out + (size_t)m * DM) + lane;
#pragma unroll
            for (int j = 0; j < 4; ++j) xr[64 * j] = xr[64 * j] * rstd * gv[j];
        }
    }
#ifdef EXP_FENCE
    asm volatile("s_waitcnt vmcnt(0)" ::: "memory"); __builtin_amdgcn_fence(__ATOMIC_RELEASE, "agent"); asm volatile("s_waitcnt vmcnt(0)" ::: "memory");
#endif
#undef IN
#undef SEAM
}

extern "C" void kernel_launch(void* const* d_in, const int* in_sizes, int n_in, void* d_out, int out_size, void* d_ws, size_t ws_size, hipStream_t stream) {
    static int grid = 0;
    if (grid == 0) {
        if (n_in != 16 || in_sizes[0] != M * DM || out_size != M * DM || ws_size < WS_END) { fprintf(stderr, "kernel_launch: unexpected problem shape (n_in %d, ws %zu)\n", n_in, ws_size); grid = -1; return; }
        int dev = 0, cus = 0, per_cu = 0;
        if (hipGetDevice(&dev) != hipSuccess || hipDeviceGetAttribute(&cus, hipDeviceAttributeMultiprocessorCount, dev) != hipSuccess) { grid = -1; return; }
        if (hipFuncSetAttribute((const void*)mk_fwd, hipFuncAttributeMaxDynamicSharedMemorySize, LDS_BYTES) != hipSuccess) { fprintf(stderr, "kernel_launch: hipFuncSetAttribute failed\n"); grid = -1; return; }
        if (hipOccupancyMaxActiveBlocksPerMultiprocessor(&per_cu, (const void*)mk_fwd, NWAVES * 64, LDS_BYTES) != hipSuccess || per_cu < 1) { fprintf(stderr, "kernel_launch: occupancy query reports %d\n", per_cu); per_cu = 1; }
        (void)hipGetLastError();
        grid = cus;
    }
    if (grid < 0) return;
#ifdef DIAG_POISON
    (void)hipMemsetAsync(d_ws, 0xFF, WS_END, stream);
#endif
    Args a{};
    for (int i = 0; i < 16; ++i) a.in[i] = (const float*)d_in[i];
    a.out = (float*)d_out; a.ws = (unsigned char*)d_ws;
    for (int li = 0; li < MK_N_LAUNCHES; ++li) {
#ifdef EXP_NO_MOBA
        if (li == 3) (void)hipMemsetAsync((char*)d_ws + WS_OA, 0, 32 * MiB, stream);
#endif
#ifdef EXP_NO_MLA
        if (li == 3) (void)hipMemsetAsync((char*)d_ws + WS_OB, 0, 32 * MiB, stream);
#endif
#ifdef EXP_SKIP_P2
        if (li == 2) continue;
#endif
#ifdef EXP_DUMP1
        if (li >= EXP_DUMP1 && li < 8) continue;
#endif
#ifdef EXP_SKIP_ATT
        if (li == 2) continue;
        if (li == 3) { (void)hipMemsetAsync((char*)d_ws + WS_OA, 0, 64 * MiB, stream); continue; }
#endif
        a.ph_lo = (MK_N_LAUNCHES == 1) ? 0 : li; a.ph_hi = (MK_N_LAUNCHES == 1) ? N_PHASES : li + 1;
        void* kargs[] = {&a};
        const hipError_t le = hipLaunchCooperativeKernel((const void*)mk_fwd, dim3(grid), dim3(NWAVES * 64), kargs, LDS_BYTES, stream);
        if (le != hipSuccess) { fprintf(stderr, "kernel_launch: launch %d failed: %s\n", li, hipGetErrorName(le)); break; }
    }
}
```

```cpp
#include <hip/hip_runtime.h>
#include <hip/hip_cooperative_groups.h>
#include <hip/hip_bf16.h>
#include <cstdio>
#include <cstdint>
#include <cmath>
namespace cg = cooperative_groups;

#ifndef MK_N_LAUNCHES
#define MK_N_LAUNCHES 1
#endif

constexpr int BATCH = 8, SEQ = 4096, DM = 1024, M = BATCH * SEQ;
constexpr int AH = 8, AW = 512;
constexpr int QL = 384, KVL = 256, ROPE = 32, QKD = 96;
constexpr int FF = 4096;
constexpr int N1 = 18 * 256;
constexpr float EPS = 1e-6f;
constexpr float LOG2E = 1.4426950408889634f;
constexpr float C2A = 0.125f * LOG2E;
constexpr float C2B = 0.10206207261596577f * LOG2E;

constexpr size_t MiB = 1u << 20;
constexpr size_t WS_WIN = 2 * MiB, WS_WUQ = 11 * MiB, WS_WUKV = 12 * MiB, WS_WPA = 13 * MiB, WS_WPB = 14 * MiB, WS_WOUT = 15 * MiB, WS_WUP = 17 * MiB, WS_WDN = 25 * MiB;
constexpr size_t WS_ROPE = 33 * MiB;
constexpr size_t WS_SSQQ = 34 * MiB, WS_SSQKV = 35 * MiB;
constexpr size_t WS_KMP = 35 * MiB + 512 * 1024;
constexpr size_t WS_HS = 36 * MiB, WS_H2S = 38 * MiB;
constexpr size_t WS_XB = 40 * MiB;
#ifdef EXP_RELOC
constexpr size_t WS_OA = 372 * MiB, WS_OB = 404 * MiB;
#else
constexpr size_t WS_OA = 40 * MiB, WS_OB = 72 * MiB;
#endif
constexpr size_t WS_QA = 104 * MiB, WS_KA = 136 * MiB, WS_VA = 168 * MiB;
constexpr size_t WS_MG = 104 * MiB;
constexpr size_t WS_HB = 168 * MiB;
constexpr size_t WS_CQ = 200 * MiB, WS_CKV = 224 * MiB, WS_KR = 240 * MiB;
constexpr size_t WS_SGA = 244 * MiB, WS_SGB = 308 * MiB;
constexpr size_t WS_QB = 372 * MiB, WS_KN = 420 * MiB, WS_VB = 452 * MiB;
constexpr size_t WS_U = 232 * MiB;
constexpr size_t WS_END = 488 * MiB;

namespace pg8 {
#define PG8_LAS __attribute__((address_space(3)))
typedef unsigned short bf16_t;
typedef short bf16x8 __attribute__((ext_vector_type(8)));
typedef float f32x4 __attribute__((ext_vector_type(4)));
typedef unsigned u32x4 __attribute__((ext_vector_type(4)));
constexpr int BM = 256, BK = 64, HALF = 128, HTB = HALF * BK * 2  , STAGE_BYTES = 8 * HTB, NXCD = 8, WGM = 8;

__host__ __device__ __forceinline__ int lds_byte(int r, int c) { const int st = (r >> 4) * 2 + (c >> 5), rr = r & 15, cc = c & 31, ob = rr * 64 + cc * 2; return st * 1024 + (ob ^ (((ob >> 9) & 1) << 5)); }
__host__ __device__ __forceinline__ void stage_rc(int b, int& R, int& C) { const int st = b / 1024, sb = b % 1024, swz = sb ^ (((sb >> 9) & 1) << 5); R = (st >> 1) * 16 + swz / 64; C = (st & 1) * 32 + (swz % 64) / 2; }
__host__ __device__ __forceinline__ int perm32(int rho) { const int n = rho >> 4, i = rho & 15; return 8 * (i >> 2) + 4 * n + (i & 3); }

struct Unit { int pm, pn; };
struct Gemm { const bf16_t* A; const bf16_t* Bt; int M, N, K; };

struct StaticOrder {
    int nM, nN, nwg, G, c;
    __host__ __device__ void init(int M, int N, int G_, int c_) { nM = M / BM; nN = N / BM; nwg = nM * nN; G = G_; c = c_; }
    __host__ __device__ bool next(int i, Unit& u) const {
        const long L = (long)i * G + c; if (L >= nwg) return false;
        int wgid = (int)L; { const int q = nwg / NXCD, r = nwg % NXCD, xcd = wgid % NXCD, off = wgid / NXCD; wgid = (xcd < r ? xcd * (q + 1) : r * (q + 1) + (xcd - r) * q) + off; }
        const int nig = WGM * nN, gid = wgid / nig, fm = gid * WGM, gsz = (nM - fm) < WGM ? (nM - fm) : WGM;
        u.pm = fm + ((wgid % nig) % gsz); u.pn = (wgid % nig) / gsz; return true;
    }
    __device__ __forceinline__ void a_ready(const Unit&) const {}
    __device__ __forceinline__ void done(const Unit&) const {}
};

__device__ __forceinline__ unsigned cvt_pk_bf16(float lo, float hi) { typedef float f2_ __attribute__((ext_vector_type(2))); typedef __bf16 b2_ __attribute__((ext_vector_type(2))); f2_ v = {lo, hi}; b2_ b = __builtin_convertvector(v, b2_); return __builtin_bit_cast(unsigned, b); }
typedef unsigned u32x2 __attribute__((ext_vector_type(2)));
__device__ __forceinline__ u32x4 pack8(f32x4 v0, f32x4 v1) { u32x4 w; w.x = cvt_pk_bf16(v0[0], v0[1]); w.y = cvt_pk_bf16(v0[2], v0[3]); w.z = cvt_pk_bf16(v1[0], v1[1]); w.w = cvt_pk_bf16(v1[2], v1[3]); return w; }
__device__ __forceinline__ u32x2 pack4(f32x4 v) { u32x2 w; w.x = cvt_pk_bf16(v[0], v[1]); w.y = cvt_pk_bf16(v[2], v[3]); return w; }
__device__ __forceinline__ float bflo(unsigned w) { return __uint_as_float(w << 16); }
__device__ __forceinline__ float bfhi(unsigned w) { return __uint_as_float(w & 0xffff0000u); }
__device__ __forceinline__ float sq4(f32x4 v) { return (v[0] * v[0] + v[1] * v[1]) + (v[2] * v[2] + v[3] * v[3]); }
__device__ __forceinline__ float red_fq(float s) { s += __shfl_xor(s, 16); s += __shfl_xor(s, 32); return s; }
__device__ __forceinline__ f32x4 sigmoid4(f32x4 v) { f32x4 o;
#pragma unroll
    for (int e = 0; e < 4; ++e) o[e] = __builtin_amdgcn_rcpf(1.0f + __builtin_amdgcn_exp2f(-1.4426950408889634f * v[e]));
    return o; }
__device__ __forceinline__ void rope_pair(f32x4& x1, f32x4& x2, const float* tab, int pos, int fq) {
    const f32x4 c = *(const f32x4*)(tab + pos * 16 + 4 * fq), s = *(const f32x4*)(tab + 65536 + pos * 16 + 4 * fq);
    const f32x4 o1 = x1 * c - x2 * s, o2 = x2 * c + x1 * s; x1 = o1; x2 = o2;
}

#define EPI_OPAQUE(fr, fq) do { int l_ = (fr) | ((fq) << 4); asm volatile("" : "+v"(l_)); (fr) = l_ & 15; (fq) = l_ >> 4; } while (0)
#define EPI_ROWS(ai, m) _Pragma("unroll") for (int ai = 0; ai < 2; ++ai) _Pragma("unroll") for (int m = 0; m < 4; ++m)

struct EpiInProj {
    static constexpr bool PERM = true, AFTER_DRAIN = false;
    unsigned char* ws;
    __device__ __forceinline__ void operator()(const f32x4 (&acc)[2][2][4][2], const Unit& u, int wr, int wc, int fr, int fq) const {
        EPI_OPAQUE(fr, fq);
        bf16_t* const QA = (bf16_t*)(ws + WS_QA); bf16_t* const KA = (bf16_t*)(ws + WS_KA); bf16_t* const VA = (bf16_t*)(ws + WS_VA); bf16_t* const CQ = (bf16_t*)(ws + WS_CQ); bf16_t* const CKV = (bf16_t*)(ws + WS_CKV);
        bf16_t* const KR = (bf16_t*)(ws + WS_KR); bf16_t* const SGA = (bf16_t*)(ws + WS_SGA); bf16_t* const SGB = (bf16_t*)(ws + WS_SGB); float* const ssq_q = (float*)(ws + WS_SSQQ); float* const ssq_kv = (float*)(ws + WS_SSQKV); const float* const rope = (const float*)(ws + WS_ROPE);
        const int pn = u.pn, row0 = u.pm * BM + wr * 64 + fr, cw = wc * 32 + 8 * fq;
        if (pn < 6) {
            bf16_t* base = (pn < 2 ? QA : pn < 4 ? KA : VA) + (pn & 1) * 256 + cw; const float sc = pn < 2 ? C2A : 1.0f;
            EPI_ROWS(ai, m) { bf16_t* rowp = base + (size_t)(row0 + ai * HALF + m * 16) * 512;
#pragma unroll
                for (int bj = 0; bj < 2; ++bj) *(u32x4*)(rowp + bj * HALF) = pack8(acc[ai][bj][m][0] * sc, acc[ai][bj][m][1] * sc); }
            if (pn == 2 || pn == 3) {
                float* const KMP = (float*)(ws + WS_KMP);
#pragma unroll
                for (int bj = 0; bj < 2; ++bj)
#pragma unroll
                    for (int n = 0; n < 2; ++n) { f32x4 s = acc[0][bj][0][n];
#pragma unroll
                        for (int k = 1; k < 8; ++k) s += acc[k >> 2][bj][k & 3][n];
#pragma unroll
                        for (int e = 0; e < 4; ++e) { float t = s[e]; t += __shfl_xor(t, 1); t += __shfl_xor(t, 2); t += __shfl_xor(t, 4); t += __shfl_xor(t, 8); s[e] = t; }
                        const int c = (pn & 1) * 256 + bj * HALF + wc * 32 + 8 * fq + 4 * n;
                        if (fr == 0) *(f32x4*)(KMP + ((size_t)(((u.pm >> 4) * 8 + (c >> 6)) * 16 + (u.pm & 15)) * 2 + wr) * 64 + (c & 63)) = s; }
            }
        } else if (pn < 8) {
            const int colt = (pn - 6) * 256;
            EPI_ROWS(ai, m) { const int row = row0 + ai * HALF + m * 16; float s = 0.f;
#pragma unroll
                for (int bj = 0; bj < 2; ++bj) { const int c = colt + bj * HALF + cw;
                    if (colt + bj * HALF < 384) { *(u32x4*)(CQ + (size_t)row * 384 + c) = pack8(acc[ai][bj][m][0], acc[ai][bj][m][1]); s += sq4(acc[ai][bj][m][0]) + sq4(acc[ai][bj][m][1]); } }
                s = red_fq(s); if (fq == 0) ssq_q[(size_t)row * 8 + (pn - 6) * 4 + wc] = s; }
        } else if (pn == 8) {
            EPI_ROWS(ai, m) { const int row = row0 + ai * HALF + m * 16; float s = 0.f;
#pragma unroll
                for (int bj = 0; bj < 2; ++bj) { *(u32x4*)(CKV + (size_t)row * 256 + bj * HALF + cw) = pack8(acc[ai][bj][m][0], acc[ai][bj][m][1]); s += sq4(acc[ai][bj][m][0]) + sq4(acc[ai][bj][m][1]); }
                s = red_fq(s); if (fq == 0) ssq_kv[(size_t)row * 4 + wc] = s; }
        } else if (pn == 9) {
            if (wc == 0) {
                EPI_ROWS(ai, m) { const int row = row0 + ai * HALF + m * 16; f32x4 x1 = acc[ai][0][m][0], x2 = acc[ai][0][m][1];
                    rope_pair(x1, x2, rope, row & (SEQ - 1), fq);
                    *(u32x2*)(KR + (size_t)row * 32 + 4 * fq) = pack4(x1); *(u32x2*)(KR + (size_t)row * 32 + 16 + 4 * fq) = pack4(x2); }
            }
        } else {
            bf16_t* base = (pn < 14 ? SGA : SGB) + ((pn - 10) & 3) * 256 + cw;
            EPI_ROWS(ai, m) { bf16_t* rowp = base + (size_t)(row0 + ai * HALF + m * 16) * 1024;
#pragma unroll
                for (int bj = 0; bj < 2; ++bj) *(u32x4*)(rowp + bj * HALF) = pack8(sigmoid4(acc[ai][bj][m][0]), sigmoid4(acc[ai][bj][m][1])); }
        }
    }
};
struct EpiQUp {
    static constexpr bool PERM = true, AFTER_DRAIN = false;
    bf16_t* QB; const float* ssq_q; const float* rope;
    __device__ __forceinline__ void operator()(const f32x4 (&acc)[2][2][4][2], const Unit& u, int wr, int wc, int fr, int fq) const {
        EPI_OPAQUE(fr, fq);
        const int row0 = u.pm * BM + wr * 64 + fr; float rs[2][4];
        EPI_ROWS(ai, m) { const int row = row0 + ai * HALF + m * 16;
            const f32x4 sa = *(const f32x4*)(ssq_q + (size_t)row * 8), sb = *(const f32x4*)(ssq_q + (size_t)row * 8 + 4);
            rs[ai][m] = C2B / sqrtf(((sa[0] + sa[1]) + (sa[2] + sa[3]) + (sb[0] + sb[1]) + (sb[2] + sb[3])) * (1.0f / 384.0f) + EPS);
            if (m == 3) asm volatile("" ::: "memory"); }
#pragma unroll
        for (int bj = 0; bj < 2; ++bj) { const int c = u.pn * BM + bj * HALF + wc * 32; const bool isrope = ((c >> 5) % 3) == 2;
            if (isrope) {
                EPI_ROWS(ai, m) { const int row = row0 + ai * HALF + m * 16; f32x4 v0 = acc[ai][bj][m][0] * rs[ai][m], v1 = acc[ai][bj][m][1] * rs[ai][m]; bf16_t* p = QB + (size_t)row * 768 + c;
                    rope_pair(v0, v1, rope, row & (SEQ - 1), fq); *(u32x2*)(p + 4 * fq) = pack4(v0); *(u32x2*)(p + 16 + 4 * fq) = pack4(v1);
                    if (m & 1) asm volatile("" ::: "memory"); }
            } else {
                EPI_ROWS(ai, m) { const int row = row0 + ai * HALF + m * 16; *(u32x4*)(QB + (size_t)row * 768 + c + 8 * fq) = pack8(acc[ai][bj][m][0] * rs[ai][m], acc[ai][bj][m][1] * rs[ai][m]); }
            }
        }
    }
};
struct EpiKVUp {
    static constexpr bool PERM = true, AFTER_DRAIN = false;
    bf16_t *KN, *VB; const float* ssq_kv;
    __device__ __forceinline__ void operator()(const f32x4 (&acc)[2][2][4][2], const Unit& u, int wr, int wc, int fr, int fq) const {
        EPI_OPAQUE(fr, fq);
        const int row0 = u.pm * BM + wr * 64 + fr; bf16_t* base = (u.pn < 2 ? KN : VB) + (u.pn & 1) * 256 + wc * 32 + 8 * fq;
        EPI_ROWS(ai, m) { const int row = row0 + ai * HALF + m * 16; const f32x4 sa = *(const f32x4*)(ssq_kv + (size_t)row * 4);
            const float rs = 1.0f / sqrtf(((sa[0] + sa[1]) + (sa[2] + sa[3])) * (1.0f / 256.0f) + EPS);
#pragma unroll
            for (int bj = 0; bj < 2; ++bj) *(u32x4*)(base + (size_t)row * 512 + bj * HALF) = pack8(acc[ai][bj][m][0] * rs, acc[ai][bj][m][1] * rs); }
    }
};
template <bool SECOND> struct EpiGate {
    static constexpr bool PERM = true, AFTER_DRAIN = false;
    bf16_t* MG; const bf16_t* SG;
    __device__ __forceinline__ void operator()(const f32x4 (&acc)[2][2][4][2], const Unit& u, int wr, int wc, int fr, int fq) const {
        EPI_OPAQUE(fr, fq);
        const int row0 = u.pm * BM + wr * 64 + fr, col0 = u.pn * BM + wc * 32 + 8 * fq;
        EPI_ROWS(ai, m) { const size_t off = (size_t)(row0 + ai * HALF + m * 16) * 1024 + col0;
#pragma unroll
            for (int bj = 0; bj < 2; ++bj) { const u32x4 g = *(const u32x4*)(SG + off + bj * HALF);
                f32x4 v0 = acc[ai][bj][m][0] * (f32x4){bflo(g.x), bfhi(g.x), bflo(g.y), bfhi(g.y)}, v1 = acc[ai][bj][m][1] * (f32x4){bflo(g.z), bfhi(g.z), bflo(g.w), bfhi(g.w)};
                if (SECOND) { const u32x4 t = *(const u32x4*)(MG + off + bj * HALF); v0 += (f32x4){bflo(t.x), bfhi(t.x), bflo(t.y), bfhi(t.y)}; v1 += (f32x4){bflo(t.z), bfhi(t.z), bflo(t.w), bfhi(t.w)}; }
                *(u32x4*)(MG + off + bj * HALF) = pack8(v0, v1); } }
    }
};
struct EpiResid {
    static constexpr bool PERM = true, AFTER_DRAIN = false;
    const float* base; float* out; bf16_t* outb; float* ss;
    __device__ __forceinline__ void operator()(const f32x4 (&acc)[2][2][4][2], const Unit& u, int wr, int wc, int fr, int fq) const {
        EPI_OPAQUE(fr, fq);
        const int row0 = u.pm * BM + wr * 64 + fr, col0 = u.pn * BM + wc * 32 + 8 * fq;
        EPI_ROWS(ai, m) { const int row = row0 + ai * HALF + m * 16; const size_t off = (size_t)row * 1024 + col0; float s = 0.f;
#pragma unroll
            for (int bj = 0; bj < 2; ++bj) { const f32x4 v0 = acc[ai][bj][m][0] + *(const f32x4*)(base + off + bj * HALF), v1 = acc[ai][bj][m][1] + *(const f32x4*)(base + off + bj * HALF + 4);
                *(f32x4*)(out + off + bj * HALF) = v0; *(f32x4*)(out + off + bj * HALF + 4) = v1; if (outb) *(u32x4*)(outb + off + bj * HALF) = pack8(v0, v1);
                s += sq4(v0) + sq4(v1); }
            s = red_fq(s); if (fq == 0) ss[(size_t)row * 16 + u.pn * 4 + wc] = s; }
    }
};
struct EpiUp {
    static constexpr bool PERM = true, AFTER_DRAIN = false;
    bf16_t* U; const float* ss;
    __device__ __forceinline__ void operator()(const f32x4 (&acc)[2][2][4][2], const Unit& u, int wr, int wc, int fr, int fq) const {
        EPI_OPAQUE(fr, fq);
        const int row0 = u.pm * BM + wr * 64 + fr, col0 = u.pn * BM + wc * 32 + 8 * fq;
        EPI_ROWS(ai, m) { const int row = row0 + ai * HALF + m * 16; const f32x4* sp = (const f32x4*)(ss + (size_t)row * 16);
            const f32x4 t = (sp[0] + sp[1]) + (sp[2] + sp[3]); const float rs = 1.0f / sqrtf(((t[0] + t[1]) + (t[2] + t[3])) * (1.0f / 1024.0f) + EPS);
#pragma unroll
            for (int bj = 0; bj < 2; ++bj) { f32x4 v0 = acc[ai][bj][m][0] * rs, v1 = acc[ai][bj][m][1] * rs;
#pragma unroll
                for (int e = 0; e < 4; ++e) { const float a = fmaxf(v0[e], 0.f), b = fmaxf(v1[e], 0.f); v0[e] = a * a; v1[e] = b * b; }
                *(u32x4*)(U + (size_t)row * FF + col0 + bj * HALF) = pack8(v0, v1); } }
    }
};
#undef EPI_ROWS
#undef EPI_OPAQUE

template <class Epi, class Sched, bool ALIGN_EPI = false, bool SP2 = false>
__device__ __forceinline__ void gemm_phase(PG8_LAS unsigned char* lds, const Gemm g, const Sched& S, const Epi& E) {
    int tid_ = threadIdx.x; asm volatile("" : "+v"(tid_));
    const int tid = tid_, wid = __builtin_amdgcn_readfirstlane(tid >> 6), lane = tid & 63, wr = wid >> 2, wc = wid & 3, fr = lane & 15, fq = lane >> 4;
    int K_ = g.K; asm volatile("" : "+s"(K_));
    const int K = K_, nt = K / BK;
    unsigned voffA[2], voffB[2];
#pragma unroll
    for (int i = 0; i < 2; ++i) { int R, C; stage_rc(tid * 16 + i * 8192, R, C); const int Rb = Epi::PERM ? ((R & ~31) + perm32(R & 31)) : R;
        voffA[i] = (unsigned)(R * K + C) * 2u; voffB[i] = (unsigned)(Rb * K + C) * 2u; }
    const size_t kstep = (size_t)(BK * 2);
    const size_t hstep = (size_t)HALF * K * 2;
    const size_t tstep = 2 * hstep;
    const unsigned ldsw = (unsigned)wid * 1024u;
    const int aoff = lds_byte(wr * 64 + fr, fq * 8), boff = lds_byte(wc * 32 + fr, fq * 8);
#define PG8_SA(b, h) (((b) * 2 + (h)) * HTB)
#define PG8_SB(b, h) ((4 + (b) * 2 + (h)) * HTB)
#define PG8_STAGE(bufoff, gbase, voff) do { _Pragma("unroll") for (int _i = 0; _i < 2; ++_i) \
        __builtin_amdgcn_global_load_lds((const unsigned*)((const char*)(gbase) + (voff)[_i]), (PG8_LAS unsigned*)(lds + (bufoff) + ldsw + _i * 8192), 16, 0, 0); } while (0)
#define PG8_LDA(dst, b, h) do { _Pragma("unroll") for (int m = 0; m < 4; ++m) _Pragma("unroll") for (int k = 0; k < 2; ++k) dst[m][k] = *(const PG8_LAS bf16x8*)(lds + PG8_SA(b, h) + aoff + m * 2048 + k * 1024); } while (0)
#define PG8_LDB(dst, b, h) do { _Pragma("unroll") for (int n = 0; n < 2; ++n) _Pragma("unroll") for (int k = 0; k < 2; ++k) dst[n][k] = *(const PG8_LAS bf16x8*)(lds + PG8_SB(b, h) + boff + n * 2048 + k * 1024); } while (0)
#define PG8_MMA(ai, bj, At, Bt) do { __builtin_amdgcn_s_setprio(1); _Pragma("unroll") for (int m = 0; m < 4; ++m) _Pragma("unroll") for (int n = 0; n < 2; ++n) _Pragma("unroll") for (int k = 0; k < 2; ++k) \
        acc[ai][bj][m][n] = __builtin_amdgcn_mfma_f32_16x16x32_bf16(Bt[n][k], At[m][k], acc[ai][bj][m][n], 0, 0, 0); __builtin_amdgcn_s_setprio(0); } while (0)
#define PG8_WAIT_V(n) asm volatile("s_waitcnt vmcnt(" #n ")" ::: "memory")
#define PG8_WAIT_L(n) asm volatile("s_waitcnt lgkmcnt(" #n ")" ::: "memory")
#define PG8_BAR __builtin_amdgcn_s_barrier()
#define PG8_SCHED __builtin_amdgcn_sched_barrier(0)
    Unit cur, nxt; int ui = 0;
    if (!S.next(0, cur)) return;
    f32x4 acc[2][2][4][2];
#pragma unroll
    for (int a = 0; a < 2; ++a)
#pragma unroll
        for (int b = 0; b < 2; ++b)
#pragma unroll
            for (int m = 0; m < 4; ++m)
#pragma unroll
                for (int n = 0; n < 2; ++n) acc[a][b][m][n] = (f32x4){0.f, 0.f, 0.f, 0.f};
    bf16x8 At[4][2], B0[2][2], B1[2][2];
    const char* cA = (const char*)g.A + (size_t)cur.pm * tstep; const char* cB = (const char*)g.Bt + (size_t)cur.pn * tstep;
    S.a_ready(cur);
    if constexpr (SP2) {
        PG8_STAGE(PG8_SB(0, 0), cB, voffB); PG8_STAGE(PG8_SB(0, 1), cB + hstep, voffB); PG8_STAGE(PG8_SA(0, 0), cA, voffA); PG8_STAGE(PG8_SA(0, 1), cA + hstep, voffA);
        if (wr == 1) PG8_BAR;
        PG8_WAIT_V(2); PG8_BAR;
        PG8_STAGE(PG8_SB(1, 0), cB + kstep, voffB); PG8_STAGE(PG8_SA(1, 0), cA + kstep, voffA); PG8_STAGE(PG8_SB(1, 1), cB + hstep + kstep, voffB);
        PG8_WAIT_V(6); PG8_BAR;
    } else {
        PG8_STAGE(PG8_SB(0, 0), cB, voffB); PG8_STAGE(PG8_SA(0, 0), cA, voffA); PG8_STAGE(PG8_SB(0, 1), cB + hstep, voffB); PG8_STAGE(PG8_SA(0, 1), cA + hstep, voffA);
        if (wr == 1) PG8_BAR;
        PG8_WAIT_V(4); PG8_BAR;
        PG8_STAGE(PG8_SB(1, 0), cB + kstep, voffB); PG8_STAGE(PG8_SA(1, 0), cA + kstep, voffA); PG8_STAGE(PG8_SB(1, 1), cB + hstep + kstep, voffB);
        PG8_WAIT_V(6); PG8_BAR;
    }
    for (;;) {
        const bool has_next = S.next(ui + 1, nxt);
        const char* nA = has_next ? (const char*)g.A + (size_t)nxt.pm * tstep : cA; const char* nB = has_next ? (const char*)g.Bt + (size_t)nxt.pn * tstep : cB;
        for (int t = 0; t < nt; t += 2) {
            const bool last = (t == nt - 2);
            const char* a1 = cA + (size_t)(t + 1) * kstep;
            const char* a2 = last ? nA : cA + (size_t)(t + 2) * kstep; const char* b2 = last ? nB : cB + (size_t)(t + 2) * kstep;
            const char* a3 = a2 + kstep; const char* b3 = b2 + kstep;
            if (last && has_next) S.a_ready(nxt);
            if constexpr (SP2) {
            PG8_LDB(B0, 0, 0); PG8_LDB(B1, 0, 1); PG8_SCHED; PG8_LDA(At, 0, 0); PG8_STAGE(PG8_SA(1, 1), a1 + hstep, voffA);
            PG8_WAIT_V(8); PG8_WAIT_L(0); PG8_BAR; PG8_MMA(0, 0, At, B0); PG8_MMA(0, 1, At, B1); PG8_BAR; PG8_SCHED;
            PG8_LDA(At, 0, 1); PG8_STAGE(PG8_SB(0, 0), b2, voffB); PG8_STAGE(PG8_SB(0, 1), b2 + hstep, voffB); PG8_STAGE(PG8_SA(0, 0), a2, voffA);
            PG8_WAIT_V(8); PG8_WAIT_L(0); PG8_BAR; PG8_MMA(1, 0, At, B0); PG8_MMA(1, 1, At, B1); PG8_BAR; PG8_SCHED;
            PG8_LDB(B0, 1, 0); PG8_LDB(B1, 1, 1); PG8_SCHED; PG8_LDA(At, 1, 0); PG8_STAGE(PG8_SA(0, 1), a2 + hstep, voffA);
            PG8_WAIT_V(8); PG8_WAIT_L(0); PG8_BAR; PG8_MMA(0, 0, At, B0); PG8_MMA(0, 1, At, B1); PG8_BAR; PG8_SCHED;
            PG8_LDA(At, 1, 1); PG8_STAGE(PG8_SB(1, 0), b3, voffB); PG8_STAGE(PG8_SB(1, 1), b3 + hstep, voffB); PG8_STAGE(PG8_SA(1, 0), a3, voffA);
            PG8_WAIT_V(8); PG8_WAIT_L(0); PG8_BAR; PG8_MMA(1, 0, At, B0); PG8_MMA(1, 1, At, B1); PG8_BAR; PG8_SCHED;
            } else {
            PG8_LDB(B0, 0, 0); PG8_SCHED; PG8_LDA(At, 0, 0); PG8_STAGE(PG8_SA(1, 1), a1 + hstep, voffA);
            PG8_WAIT_L(8); PG8_BAR; PG8_WAIT_L(0); PG8_MMA(0, 0, At, B0); PG8_BAR; PG8_SCHED;
            PG8_LDB(B1, 0, 1); PG8_STAGE(PG8_SB(0, 0), b2, voffB);
            PG8_BAR; PG8_WAIT_L(0); PG8_MMA(0, 1, At, B1); PG8_BAR;
            PG8_LDA(At, 0, 1); PG8_STAGE(PG8_SA(0, 0), a2, voffA);
            PG8_BAR; PG8_WAIT_L(0); PG8_MMA(1, 0, At, B0); PG8_BAR; PG8_SCHED;
            PG8_STAGE(PG8_SB(0, 1), b2 + hstep, voffB);
            PG8_WAIT_V(6); PG8_BAR; PG8_MMA(1, 1, At, B1); PG8_BAR;
            PG8_LDB(B0, 1, 0); PG8_SCHED; PG8_LDA(At, 1, 0); PG8_STAGE(PG8_SA(0, 1), a2 + hstep, voffA);
            PG8_WAIT_L(8); PG8_BAR; PG8_WAIT_L(0); PG8_MMA(0, 0, At, B0); PG8_BAR; PG8_SCHED;
            PG8_LDB(B1, 1, 1); PG8_STAGE(PG8_SB(1, 0), b3, voffB);
            PG8_BAR; PG8_WAIT_L(0); PG8_MMA(0, 1, At, B1); PG8_BAR;
            PG8_LDA(At, 1, 1); PG8_STAGE(PG8_SA(1, 0), a3, voffA);
            PG8_BAR; PG8_WAIT_L(0); PG8_MMA(1, 0, At, B0); PG8_BAR; PG8_SCHED;
            PG8_STAGE(PG8_SB(1, 1), b3 + hstep, voffB);
            PG8_WAIT_V(6); PG8_BAR; PG8_MMA(1, 1, At, B1); PG8_BAR;
            }
        }
        if constexpr (ALIGN_EPI) { if (wr == 0) PG8_BAR; }
        if constexpr (!Epi::AFTER_DRAIN) { E(acc, cur, wr, wc, fr, fq); S.done(cur); }
        if (!has_next) break;
#pragma unroll
        for (int a = 0; a < 2; ++a)
#pragma unroll
            for (int b = 0; b < 2; ++b)
#pragma unroll
                for (int m = 0; m < 4; ++m)
#pragma unroll
                    for (int n = 0; n < 2; ++n) acc[a][b][m][n] = (f32x4){0.f, 0.f, 0.f, 0.f};
        cur = nxt; cA = nA; cB = nB; ++ui;
        if constexpr (ALIGN_EPI) { if (wr == 1) PG8_BAR; }
    }
    PG8_WAIT_V(0);
    if constexpr (!ALIGN_EPI) { if (wr == 0) PG8_BAR; }
    PG8_BAR;
    if constexpr (Epi::AFTER_DRAIN) { E.fused(acc, cur, wr, wc, fr, fq, lds, wid, lane); S.done(cur); }
#undef PG8_SA
#undef PG8_SB
#undef PG8_STAGE
#undef PG8_LDA
#undef PG8_LDB
#undef PG8_MMA
#undef PG8_WAIT_V
#undef PG8_WAIT_L
#undef PG8_BAR
#undef PG8_SCHED
}
}
namespace att {
#define ALAS __attribute__((address_space(3)))
typedef short bf16x8 __attribute__((ext_vector_type(8)));
typedef short s16x4 __attribute__((ext_vector_type(4)));
typedef float f32x16 __attribute__((ext_vector_type(16)));
typedef float f32x4 __attribute__((ext_vector_type(4)));
typedef unsigned u32x4 __attribute__((ext_vector_type(4)));
typedef unsigned short bf16_t;
constexpr int K_SLOT = 12288, V_SLOT = 8192;
constexpr int NSLOT = 3;
constexpr int L_K = 0, L_V = NSLOT * K_SLOT, L_WS = L_V + NSLOT * V_SLOT, L_LUT = L_WS + 2048, L_KM = L_LUT + 1024, L_OST = L_KM + 8192, L_END = L_OST + 32768;
constexpr float THR = 8.0f;
__device__ __forceinline__ int crow(int r, int hi) { return (r & 3) + 8 * (r >> 2) + 4 * hi; }
__device__ __forceinline__ unsigned cvtpk(float lo, float hi) { typedef float f2 __attribute__((ext_vector_type(2))); typedef __bf16 b2 __attribute__((ext_vector_type(2))); f2 v = {lo, hi}; b2 b = __builtin_convertvector(v, b2); return __builtin_bit_cast(unsigned, b); }
__device__ __forceinline__ float swapmax(float m) { auto rr = __builtin_amdgcn_permlane32_swap(__float_as_uint(m), __float_as_uint(m), false, false); return fmaxf(__uint_as_float(rr[0]), __uint_as_float(rr[1])); }
__device__ __forceinline__ float swapsum(float m) { auto rr = __builtin_amdgcn_permlane32_swap(__float_as_uint(m), __float_as_uint(m), false, false); return __uint_as_float(rr[0]) + __uint_as_float(rr[1]); }
typedef short v4i16_t __attribute__((ext_vector_type(4)));
__device__ __forceinline__ s16x4 vtr(const ALAS unsigned char* p) { return __builtin_bit_cast(s16x4, __builtin_amdgcn_ds_read_tr16_b64_v4i16((ALAS v4i16_t*)p)); }
__device__ __forceinline__ int t5_bucket(int d) {
    if (d < 16) return d;
    int b = 16; b += d >= 19; b += d >= 21; b += d >= 24; b += d >= 27; b += d >= 31; b += d >= 35; b += d >= 40; b += d >= 46; b += d >= 52; b += d >= 59; b += d >= 67; b += d >= 77; b += d >= 87; b += d >= 99; b += d >= 113;
    return b;
}
__device__ __forceinline__ void glds16(const void* gsrc, unsigned lds_dst) { unsigned keep;
    asm volatile("s_mov_b32 %0, m0\n\ts_mov_b32 m0, %2\n\ts_nop 0\n\tglobal_load_lds_dwordx4 %1, off\n\ts_mov_b32 m0, %0" : "=&s"(keep) : "v"(gsrc), "s"(lds_dst) : "memory"); }
#define WAITB(N) asm volatile("s_waitcnt vmcnt(" #N ") lgkmcnt(0)\n\ts_barrier" ::: "memory")
struct AttnArgs { const bf16_t *QA, *KA, *VA, *QB, *KN, *KR, *VB; const float* KMP; bf16_t *OA, *OB; const float* rel_bias; };

template <int MODE>
__device__ __forceinline__ void attn_unit(ALAS unsigned char* shm, const AttnArgs& A, int b, int h, int n) {
    constexpr int ND = MODE ? 6 : 4;
    int tid_ = threadIdx.x; asm volatile("" : "+v"(tid_));
    const int tid = tid_, lane = tid & 63, r32 = lane & 31, hi = lane >> 5; const int wid = __builtin_amdgcn_readfirstlane(tid >> 6);
    const long rowbase = (long)b * SEQ; const int q0 = n * 256, NT = 4 * (n + 1), qrel = wid * 32 + r32;
    ALAS float* wsf = (ALAS float*)(shm + L_WS) + wid * 64;
    ALAS float* lut = (ALAS float*)(shm + L_LUT);
    ALAS unsigned char* ost = shm + L_OST + wid * 4096;
    const bf16_t* Kg = (MODE ? A.KN : A.KA) + (size_t)lane * 512 + h * 64 + wid * 8;
    const bf16_t* Kr = A.KR + (size_t)lane * 32 + (wid & 3) * 8;
    const bf16_t* Vg = (MODE ? A.VB : A.VA) + (size_t)(16 * (wid & 3) + (lane >> 2)) * 512 + h * 64 + (wid >> 2) * 32 + (lane & 3) * 8;
    const unsigned lds0 = (unsigned)(size_t)shm;
#define TILE_ROW(i) (MODE ? (rowbase + 64 * (i)) : (rowbase + 256 * (((i) < 4) ? n : n - ((i) >> 2)) + 64 * ((i) & 3)))
#define DMA(i, s) do { const long r0_ = TILE_ROW(i); glds16(Kg + r0_ * 512, (unsigned)__builtin_amdgcn_readfirstlane(lds0 + L_K + (s) * K_SLOT + wid * 1024)); \
        if (MODE && wid < 4) glds16(Kr + r0_ * 32, (unsigned)__builtin_amdgcn_readfirstlane(lds0 + L_K + (s) * K_SLOT + (8 + wid) * 1024)); \
        glds16(Vg + r0_ * 512, (unsigned)__builtin_amdgcn_readfirstlane(lds0 + L_V + (s) * V_SLOT + wid * 1024)); } while (0)
    DMA(0, 0); DMA(1, 1);
    bf16x8 qr[ND];
    { const bf16_t* Qw = MODE ? (A.QB + (size_t)(rowbase + q0 + qrel) * 768 + h * 96) : (A.QA + (size_t)(rowbase + q0 + qrel) * 512 + h * 64);
#pragma unroll
      for (int d0 = 0; d0 < ND; ++d0) qr[d0] = *(const bf16x8*)(Qw + d0 * 16 + hi * 8); }
    unsigned selmask = 0u; float c31 = 0.f;
    if (MODE == 0) {
        if (tid < 128) lut[tid] = A.rel_bias[t5_bucket(tid) * 8 + h] * LOG2E;
        if (tid < 128) { const int c = tid >> 4, blk = tid & 15; const float* src = A.KMP + ((size_t)((b * 8 + h) * 16 + blk) * 2) * 64 + c * 8;
            const f32x4 a0 = *(const f32x4*)src, a1 = *(const f32x4*)(src + 4), b0 = *(const f32x4*)(src + 64), b1 = *(const f32x4*)(src + 68);
            const f32x4 m0 = (a0 + b0) * (1.0f / 256.0f), m1 = (a1 + b1) * (1.0f / 256.0f); u32x4 vh, vl;
#pragma unroll
            for (int e = 0; e < 2; ++e) { const unsigned h0 = cvtpk(m0[2 * e], m0[2 * e + 1]), h1 = cvtpk(m1[2 * e], m1[2 * e + 1]); vh[e] = h0; vh[2 + e] = h1;
                vl[e] = cvtpk(m0[2 * e] - __uint_as_float(h0 << 16), m0[2 * e + 1] - __uint_as_float(h0 & 0xffff0000u)); vl[2 + e] = cvtpk(m1[2 * e] - __uint_as_float(h1 << 16), m1[2 * e + 1] - __uint_as_float(h1 & 0xffff0000u)); }
            *(ALAS u32x4*)(shm + L_KM + c * 512 + blk * 16) = vh; *(ALAS u32x4*)(shm + L_KM + 4096 + c * 512 + blk * 16) = vl;
        } else if (tid < 384) { const int t2 = tid - 128, which = t2 >> 7, c = (t2 >> 4) & 7, row = 16 + (t2 & 15); *(ALAS u32x4*)(shm + L_KM + which * 4096 + c * 512 + row * 16) = (u32x4){0u, 0u, 0u, 0u}; }
    }
    asm volatile("s_waitcnt vmcnt(0) lgkmcnt(0)" ::: "memory");
    __syncthreads();
    if (MODE == 0) {
        c31 = lut[127];
        if (n > 0) {
            f32x16 g = {};
#pragma unroll
            for (int d0 = 0; d0 < 4; ++d0) {
                const bf16x8 ah = *(const ALAS bf16x8*)(shm + L_KM + (2 * d0 + hi) * 512 + r32 * 16), al = *(const ALAS bf16x8*)(shm + L_KM + 4096 + (2 * d0 + hi) * 512 + r32 * 16);
                g = __builtin_amdgcn_mfma_f32_32x32x16_bf16(ah, qr[d0], g, 0, 0, 0); g = __builtin_amdgcn_mfma_f32_32x32x16_bf16(al, qr[d0], g, 0, 0, 0); }
            ALAS float* gs = (ALAS float*)ost;
            *(ALAS f32x4*)(gs + r32 * 16 + 4 * hi) = (f32x4){g[0], g[1], g[2], g[3]}; *(ALAS f32x4*)(gs + r32 * 16 + 8 + 4 * hi) = (f32x4){g[4], g[5], g[6], g[7]};
            asm volatile("s_waitcnt lgkmcnt(0)" ::: "memory");
            float gg[16];
#pragma unroll
            for (int j4 = 0; j4 < 4; ++j4) { const f32x4 t = *(const ALAS f32x4*)(gs + r32 * 16 + 4 * j4); gg[4 * j4] = t[0]; gg[4 * j4 + 1] = t[1]; gg[4 * j4 + 2] = t[2]; gg[4 * j4 + 3] = t[3]; }
            asm volatile("s_waitcnt lgkmcnt(0)" ::: "memory");
#pragma unroll
            for (int k = 0; k < 3; ++k) { float best = -INFINITY; int bi = -1;
#pragma unroll
                for (int j = 0; j < 16; ++j) { const bool ok = (j < n) && !((selmask >> j) & 1u) && (gg[j] > best); best = ok ? gg[j] : best; bi = ok ? j : bi; }
                if (bi >= 0) selmask |= 1u << bi; }
        }
    }
#ifdef EXP_ALLSEL
    selmask = 0xffffu;
#endif
    float mhat = 0.f, l_reg = 0.f, badd = 0.f; f32x16 o[2]; o[0] = f32x16{}; o[1] = f32x16{}; f32x16 cin = f32x16{};
    const ALAS unsigned char* kp0 = shm + L_K + hi * 1024 + r32 * 16;
    const ALAS unsigned char* vp0 = shm + L_V + ((lane >> 4) & 1) * 32 + (lane & 3) * 8 + (4 * hi + ((lane & 15) >> 2)) * 64;
    bf16x8 kf[2 * ND];
#pragma unroll
    for (int d0 = 0; d0 < ND; ++d0) { kf[2 * d0] = *(const ALAS bf16x8*)(kp0 + d0 * 2048); kf[2 * d0 + 1] = *(const ALAS bf16x8*)(kp0 + d0 * 2048 + 512); }
    int s_cur = 0, s_nxt = 1, s_nn = 2;
    for (int i = 0; i < NT; ++i) {
        if (i + 2 < NT) DMA(i + 2, s_nn);
        s16x4 vl[8], vh[8];
        { const ALAS unsigned char* vp = vp0 + s_cur * V_SLOT;
#pragma unroll
          for (int j = 0; j < 8; ++j) { vl[j] = vtr(vp + (j >> 2) * 4096 + (j & 3) * 1024); vh[j] = vtr(vp + (j >> 2) * 4096 + (j & 3) * 1024 + 512); } }
        const int kb = MODE ? 0 : (i >> 2), t4 = i & 3;
        const int jb = MODE ? (i - (NT - 4)) : (kb == 0 ? t4 : -1);
        const bool active = !(jb >= 0 && 64 * jb > 32 * wid + 31);
        u32x4 pw[4];
        if (active) {
            if (MODE == 0 && t4 == 0 && i > 0) {
                const int blk = n - kb; const bool sel = (selmask >> blk) & 1u;
                badd = sel ? (kb >= 2 ? c31 : 0.f) : -INFINITY; const float cv = badd - mhat;
#pragma unroll
                for (int r = 0; r < 16; ++r) cin[r] = cv;
            }
            f32x16 p0 = __builtin_amdgcn_mfma_f32_32x32x16_bf16(kf[0], qr[0], cin, 0, 0, 0), p1 = __builtin_amdgcn_mfma_f32_32x32x16_bf16(kf[1], qr[0], cin, 0, 0, 0);
#pragma unroll
            for (int d0 = 1; d0 < ND; ++d0) { p0 = __builtin_amdgcn_mfma_f32_32x32x16_bf16(kf[2 * d0], qr[d0], p0, 0, 0, 0); p1 = __builtin_amdgcn_mfma_f32_32x32x16_bf16(kf[2 * d0 + 1], qr[d0], p1, 0, 0, 0); }
            if (MODE == 1) {
                if (jb >= 0) { const int kb0 = 64 * jb + 4 * hi;
#pragma unroll
                    for (int r = 0; r < 16; ++r) { const int kv = kb0 + (r & 3) + 8 * (r >> 2); if (kv > qrel) p0[r] = -INFINITY; if (kv + 32 > qrel) p1[r] = -INFINITY; } }
            } else if (kb <= 1) {
                const int dmin = 32 * wid + (kb ? 256 : 0) - 64 * t4 - 63;
                if (dmin >= 113) {
#pragma unroll
                    for (int r = 0; r < 16; ++r) { p0[r] += c31; p1[r] += c31; }
                } else { const int d0_ = qrel + (kb ? 256 : 0) - (64 * t4 + 4 * hi); float ba[16], bb[16];
#pragma unroll
                    for (int r = 0; r < 16; ++r) { const int da = d0_ - ((r & 3) + 8 * (r >> 2)), db = da - 32; ba[r] = lut[min(max(da, 0), 127)]; bb[r] = lut[min(max(db, 0), 127)]; }
#pragma unroll
                    for (int r = 0; r < 16; ++r) { const int da = d0_ - ((r & 3) + 8 * (r >> 2)), db = da - 32; p0[r] = da < 0 ? -INFINITY : p0[r] + ba[r]; p1[r] = db < 0 ? -INFINITY : p1[r] + bb[r]; } }
            }
            float rm = fmaxf(p0[0], p1[0]);
#pragma unroll
            for (int r = 1; r < 16; ++r) rm = fmaxf(rm, fmaxf(p0[r], p1[r]));
            rm = swapmax(rm);
            if (i == 0) {
                const float dl = rm; mhat = dl;
#pragma unroll
                for (int r = 0; r < 16; ++r) { p0[r] -= dl; p1[r] -= dl; cin[r] = badd - mhat; }
            } else if (__any(rm > THR)) {
                const float dl = fmaxf(rm, 0.f); mhat += dl; const float f = __builtin_amdgcn_exp2f(-dl); l_reg *= f;
#pragma unroll
                for (int r = 0; r < 16; ++r) { p0[r] -= dl; p1[r] -= dl; cin[r] = badd - mhat; }
                if (hi == 0) wsf[r32] = f;
                asm volatile("s_waitcnt lgkmcnt(0)" ::: "memory");
#pragma unroll
                for (int r = 0; r < 16; ++r) { const float fr_ = wsf[crow(r, hi)]; o[0][r] *= fr_; o[1][r] *= fr_; }
            }
            float sacc = 0.f;
#pragma unroll
            for (int r = 0; r < 16; ++r) { p0[r] = __builtin_amdgcn_exp2f(p0[r]); p1[r] = __builtin_amdgcn_exp2f(p1[r]); sacc += p0[r] + p1[r]; }
            l_reg += sacc;
#pragma unroll
            for (int e = 0; e < 4; ++e) { pw[0][e] = cvtpk(p0[2 * e], p0[2 * e + 1]); pw[1][e] = cvtpk(p0[8 + 2 * e], p0[9 + 2 * e]); pw[2][e] = cvtpk(p1[2 * e], p1[2 * e + 1]); pw[3][e] = cvtpk(p1[8 + 2 * e], p1[9 + 2 * e]); }
        }
        if (i + 2 < NT) { if (MODE && wid < 4) WAITB(3); else WAITB(2); } else WAITB(0);
        if (i + 1 < NT) { const ALAS unsigned char* kp = kp0 + s_nxt * K_SLOT;
#pragma unroll
            for (int d0 = 0; d0 < ND; ++d0) { kf[2 * d0] = *(const ALAS bf16x8*)(kp + d0 * 2048); kf[2 * d0 + 1] = *(const ALAS bf16x8*)(kp + d0 * 2048 + 512); } }
        if (active) {
#pragma unroll
            for (int ks = 0; ks < 4; ++ks)
#pragma unroll
                for (int d0 = 0; d0 < 2; ++d0) { const int j = d0 * 4 + ks; const bf16x8 vf = (bf16x8){vl[j][0], vl[j][1], vl[j][2], vl[j][3], vh[j][0], vh[j][1], vh[j][2], vh[j][3]};
                    o[d0] = __builtin_amdgcn_mfma_f32_32x32x16_bf16(__builtin_bit_cast(bf16x8, pw[ks]), vf, o[d0], 0, 0, 0); }
        }
        { const int t_ = s_cur; s_cur = s_nxt; s_nxt = s_nn; s_nn = t_; }
    }
    __syncthreads();
    l_reg = swapsum(l_reg);
    if (hi == 0) wsf[32 + r32] = l_reg;
    asm volatile("s_waitcnt lgkmcnt(0)" ::: "memory");
    { ALAS bf16_t* stg = (ALAS bf16_t*)ost;
#pragma unroll
      for (int r = 0; r < 16; ++r) { const int orow = crow(r, hi); const float rl = __builtin_amdgcn_rcpf(wsf[32 + orow]);
#pragma unroll
          for (int d0 = 0; d0 < 2; ++d0) stg[orow * 64 + d0 * 32 + r32] = (bf16_t)(cvtpk(o[d0][r] * rl, 0.f) & 0xffffu); }
      asm volatile("s_waitcnt lgkmcnt(0)" ::: "memory");
      bf16_t* Ow = (MODE ? A.OB : A.OA) + (size_t)(rowbase + q0 + wid * 32) * 512 + h * 64;
#pragma unroll
      for (int i2 = 0; i2 < 4; ++i2) { const int row = i2 * 8 + (lane >> 3), ch = lane & 7; const u32x4 v = *(const ALAS u32x4*)(stg + row * 64 + ch * 8); *(u32x4*)(Ow + (size_t)row * 512 + ch * 8) = v; } }
    __syncthreads();
#undef TILE_ROW
#undef DMA
}
}

constexpr int NWAVES = 8;
constexpr int N_PHASES = 9;
constexpr int RING_BYTES = 131072;
constexpr int LDS_BYTES = 147456;
static_assert(att::L_END <= RING_BYTES, "attention scratch inside the ring region");

#define GAS __attribute__((address_space(1)))
#define LAS __attribute__((address_space(3)))
typedef unsigned short bf16;
typedef unsigned v4u __attribute__((ext_vector_type(4)));
typedef float f32x4 __attribute__((ext_vector_type(4)));
#define LDS_WAIT() asm volatile("s_waitcnt lgkmcnt(0)" ::: "memory")
__device__ __forceinline__ unsigned f2bf(float f) { unsigned u = __builtin_bit_cast(unsigned, f); return (u + 0x7fffu + ((u >> 16) & 1u)) >> 16; }
__device__ __forceinline__ unsigned pk2(float lo, float hi) { return f2bf(lo) | (f2bf(hi) << 16); }
__device__ __forceinline__ float wave_sum(float v) {
#pragma unroll
    for (int o = 1; o < 64; o <<= 1) v += __shfl_xor(v, o);
    return v;
}
__device__ __forceinline__ void p0_item(const float* W, int K, int Ns, bf16* WT, int gd, int gs, bool rope, const float* gain, LAS float* scr, int kb, int lane) {
    const int k0 = 64 * kb, c = lane & 7;
    if (gs < 0) {
#pragma unroll
        for (int j = 0; j < 4; ++j) { const int n = (lane >> 3) + 8 * j; *(v4u*)(WT + (size_t)(32 * gd + n) * K + k0 + 8 * c) = (v4u){0u, 0u, 0u, 0u}; }
        return;
    }
#pragma unroll 8
    for (int i = 0; i < 32; ++i) { const int kk = 2 * i + (lane >> 5); const float g = gain ? gain[k0 + kk] : 1.0f; scr[kk * 33 + (lane & 31)] = W[(size_t)(k0 + kk) * Ns + 32 * gs + (lane & 31)] * g; }
    LDS_WAIT(); asm volatile("" ::: "memory");
#pragma unroll
    for (int j = 0; j < 4; ++j) { const int n = (lane >> 3) + 8 * j; const int ns = rope ? (4 * (n >> 3) + (n & 3) + 16 * ((n >> 2) & 1)) : n; const LAS float* s = scr + (8 * c) * 33 + ns;
        v4u o; o.x = pk2(s[0 * 33], s[1 * 33]); o.y = pk2(s[2 * 33], s[3 * 33]); o.z = pk2(s[4 * 33], s[5 * 33]); o.w = pk2(s[6 * 33], s[7 * 33]);
        *(v4u*)(WT + (size_t)(32 * gd + n) * K + k0 + 8 * c) = o; }
    LDS_WAIT(); asm volatile("" ::: "memory");
}

typedef GAS unsigned gu32;
#define RLX_AGENT __ATOMIC_RELAXED, __HIP_MEMORY_SCOPE_AGENT
#define XB_TMO      128
#define XB_XCNT(j)  (256  + 64 * (j))
#define XB_XSUB(j)  (1280 + 64 * (j))
#define XB_XGEN(j)  (2304 + 64 * (j))
#define XB_TOP      3328
#define XB_TOPGEN   3392
#define XCD_BAR_WORDS 3456
#define XB_SPIN_CAP (1u << 18)

__device__ __forceinline__ unsigned xb_ld(unsigned* p)              { return __hip_atomic_load(p, __ATOMIC_RELAXED, __HIP_MEMORY_SCOPE_AGENT); }
__device__ __forceinline__ unsigned xb_add(unsigned* p, unsigned v) { return __hip_atomic_fetch_add(p, v, __ATOMIC_RELAXED, __HIP_MEMORY_SCOPE_AGENT); }
__device__ __forceinline__ unsigned xb_xcc_id() { return (unsigned)__builtin_amdgcn_s_getreg((3 << 11) | 20) & 0xFu; }
#define XB_SPIN(cond, bar) do { unsigned _sp = 0; while (cond) { __builtin_amdgcn_s_sleep(1); \
    if ((++_sp & 255u) == 0u) { if (xb_ld(&(bar)[XB_TMO])) break; if (_sp > XB_SPIN_CAP) { atomicAdd(&(bar)[XB_TMO], 1u); break; } } } } while (0)

struct XcdBarrier {
    unsigned* bar; unsigned x;
    volatile LAS unsigned* st;
};

__device__ __forceinline__ XcdBarrier xcd_barrier_post(unsigned* bar, volatile LAS unsigned* st) {
    XcdBarrier b; b.bar = bar; b.x = xb_xcc_id(); b.st = st;
    if (threadIdx.x == 0) (void)xb_add(&bar[XB_XCNT(b.x)], 1u);
    return b;
}
__device__ __forceinline__ void xcd_barrier_complete(unsigned* bar, unsigned x, unsigned& nloc, unsigned& nx) {
    const unsigned G = gridDim.x * gridDim.y * gridDim.z;
    unsigned sum, cnt, mine, sp = 0u;
    for (;;) {
        sum = 0u; cnt = 0u; mine = 0u;
#pragma unroll
        for (unsigned j = 0; j < 16; ++j) { const unsigned c = xb_ld(&bar[XB_XCNT(j)]); sum += c; cnt += (c > 0u) ? 1u : 0u; mine = (j == x) ? c : mine; }
        if (sum == G) break;
        __builtin_amdgcn_s_sleep(1);
        if ((++sp & 255u) == 0u) { if (xb_ld(&bar[XB_TMO])) break; if (sp > XB_SPIN_CAP) { atomicAdd(&bar[XB_TMO], 1u); break; } }
    }
    nloc = mine > 0u ? mine : 1u; nx = cnt > 0u ? cnt : 1u;
}

__device__ __forceinline__ void xcd_barrier(const XcdBarrier& b) {
    asm volatile("s_waitcnt vmcnt(0)" ::: "memory");
    __syncthreads();
    if (threadIdx.x == 0) {
        unsigned* bar = b.bar;
        __builtin_amdgcn_s_waitcnt(0);
        unsigned nloc = b.st[0], nx = b.st[1];
        if (nloc == 0u) { xcd_barrier_complete(bar, b.x, nloc, nx); b.st[0] = nloc; b.st[1] = nx; }
        const unsigned old = xb_add(&bar[XB_XSUB(b.x)], 1u);
        const unsigned gen = old / nloc;
        if (old + 1u == (gen + 1u) * nloc) {
            __builtin_amdgcn_fence(__ATOMIC_RELEASE, "agent");
            asm volatile("s_waitcnt vmcnt(0)" ::: "memory");
            const unsigned og = xb_add(&bar[XB_TOP], 1u);
            const unsigned tg = og / nx;
            if (og + 1u == (tg + 1u) * nx) xb_add(&bar[XB_TOPGEN], 1u);
            else XB_SPIN(xb_ld(&bar[XB_TOPGEN]) == tg, bar);
            __builtin_amdgcn_fence(__ATOMIC_ACQUIRE, "agent");
            xb_add(&bar[XB_XGEN(b.x)], 1u);
            asm volatile("s_waitcnt vmcnt(0)" ::: "memory");
        } else {
            XB_SPIN(xb_ld(&bar[XB_XGEN(b.x)]) == gen, bar);
            __builtin_amdgcn_fence(__ATOMIC_ACQUIRE, "agent");
            asm volatile("s_waitcnt vmcnt(0)" ::: "memory");
        }
    }
    __syncthreads();
}

struct Args { const float* in[16]; float* out; unsigned char* ws; int ph_lo, ph_hi; };
enum { I_X = 0, I_WIN, I_RELB, I_QNORM, I_WUQ, I_KVNORM, I_WUK, I_WUV, I_WPA, I_WPB, I_WOUT, I_NATTN, I_NMLP, I_WUP, I_WDN, I_NFIN };

__global__ void __launch_bounds__(NWAVES * 64, 2) mk_fwd(Args args) {
    extern __shared__ __attribute__((aligned(16))) unsigned char lds_raw[];
    LAS unsigned char* lds = (LAS unsigned char*)lds_raw;
    const int tid = threadIdx.x, lane = tid & 63, wave = __builtin_amdgcn_readfirstlane(tid >> 6);
    const int G = gridDim.x, bx = blockIdx.x, vcu = (G % 8 == 0) ? (bx % 8) * (G / 8) + bx / 8 : bx;
    unsigned char* ws = args.ws;
    const int lo = args.ph_lo, hi = args.ph_hi;
    cg::grid_group grid = cg::this_grid();
    volatile LAS unsigned* MISC = (volatile LAS unsigned*)(lds + RING_BYTES + 320);
    if (tid < 32) MISC[tid] = 0u;
    __syncthreads();
    XcdBarrier bar = xcd_barrier_post((unsigned*)ws, MISC + 8);
#ifndef PH_MASK
#define PH_MASK 0x1ff
#endif
#define IN(k) (((PH_MASK >> (k)) & 1) && lo <= (k) && (k) < hi)
#ifndef PROBE_DOUBLE
#define PROBE_DOUBLE -1
#endif
#define REPS(k) for (int rep_ = 0; rep_ < ((k) == PROBE_DOUBLE ? 2 : 1); ++rep_, ((k) == PROBE_DOUBLE && rep_ == 1) ? grid.sync() : (void)0)
#define SEAM(k) do { if (IN(k) && IN((k) + 1)) { if ((k) == 0) grid.sync(); else xcd_barrier(bar); } } while (0)
    bf16* Win_t = (bf16*)(ws + WS_WIN); bf16* Wuq_t = (bf16*)(ws + WS_WUQ); bf16* Wukv_t = (bf16*)(ws + WS_WUKV); bf16* Wpa_t = (bf16*)(ws + WS_WPA); bf16* Wpb_t = (bf16*)(ws + WS_WPB);
    bf16* Wout_t = (bf16*)(ws + WS_WOUT); bf16* Wup_t = (bf16*)(ws + WS_WUP); bf16* Wdn_t = (bf16*)(ws + WS_WDN);
    float* ropetab = (float*)(ws + WS_ROPE); float* ssq_q = (float*)(ws + WS_SSQQ); float* ssq_kv = (float*)(ws + WS_SSQKV); float* hs = (float*)(ws + WS_HS); float* h2s = (float*)(ws + WS_H2S);
    const float* KMP = (const float*)(ws + WS_KMP);
    bf16* XB = (bf16*)(ws + WS_XB); bf16* OA = (bf16*)(ws + WS_OA); bf16* OB = (bf16*)(ws + WS_OB); bf16* QA = (bf16*)(ws + WS_QA); bf16* KA = (bf16*)(ws + WS_KA); bf16* VA = (bf16*)(ws + WS_VA);
    bf16* MG = (bf16*)(ws + WS_MG); bf16* HB = (bf16*)(ws + WS_HB); bf16* CQ = (bf16*)(ws + WS_CQ); bf16* CKV = (bf16*)(ws + WS_CKV); bf16* KR = (bf16*)(ws + WS_KR);
    bf16* SGA = (bf16*)(ws + WS_SGA); bf16* SGB = (bf16*)(ws + WS_SGB); bf16* QB = (bf16*)(ws + WS_QB); bf16* KN = (bf16*)(ws + WS_KN); bf16* VB = (bf16*)(ws + WS_VB); bf16* U = (bf16*)(ws + WS_U);
    const int gw = vcu * NWAVES + wave, NGW = G * NWAVES;
#ifdef EXP_FENCE
    __builtin_amdgcn_fence(__ATOMIC_ACQUIRE, "agent"); asm volatile("s_waitcnt vmcnt(0)" ::: "memory"); __syncthreads();
#endif

    REPS(0) if (IN(0)) {
        LAS float* scr = (LAS float*)(lds + wave * 16384);
        constexpr int G_IN = N1 / 32, I_IN = (DM / 64) * G_IN;
        constexpr int I_UQ = (QL / 64) * 24, I_UK = (KVL / 64) * 16, I_UV = I_UK, I_PA = (AW / 64) * 32, I_PB = I_PA, I_OUT = (DM / 64) * 32, I_UP = (DM / 64) * 128, I_DN = (FF / 64) * 32;
        constexpr int NITEMS = I_IN + I_UQ + I_UK + I_UV + I_PA + I_PB + I_OUT + I_UP + I_DN;
        for (int it = gw; it < NITEMS; it += NGW) {
            int r = it;
            if (r < I_IN) { const int kb = r / G_IN, gd = r % G_IN; int gs; bool rp = false;
                if (gd < 60) gs = gd; else if (gd < 64) gs = -1; else if (gd < 72) gs = gd - 4; else if (gd == 72) { gs = 68; rp = true; } else if (gd < 80) gs = -1; else gs = gd - 11;
                p0_item(args.in[I_WIN], DM, 4256, Win_t, gd, gs, rp, args.in[I_NATTN], scr, kb, lane); continue; } r -= I_IN;
            if (r < I_UQ) { const int kb = r / 24, gd = r % 24; p0_item(args.in[I_WUQ], QL, 768, Wuq_t, gd, gd, (gd % 3) == 2, args.in[I_QNORM], scr, kb, lane); continue; } r -= I_UQ;
            if (r < I_UK) { const int kb = r / 16, gd = r % 16; p0_item(args.in[I_WUK], KVL, 512, Wukv_t, gd, gd, false, args.in[I_KVNORM], scr, kb, lane); continue; } r -= I_UK;
            if (r < I_UV) { const int kb = r / 16, gd = r % 16; p0_item(args.in[I_WUV], KVL, 512, Wukv_t, 16 + gd, gd, false, args.in[I_KVNORM], scr, kb, lane); continue; } r -= I_UV;
            if (r < I_PA) { const int kb = r / 32, gd = r % 32; p0_item(args.in[I_WPA], AW, 1024, Wpa_t, gd, gd, false, nullptr, scr, kb, lane); continue; } r -= I_PA;
            if (r < I_PB) { const int kb = r / 32, gd = r % 32; p0_item(args.in[I_WPB], AW, 1024, Wpb_t, gd, gd, false, nullptr, scr, kb, lane); continue; } r -= I_PB;
            if (r < I_OUT) { const int kb = r / 32, gd = r % 32; p0_item(args.in[I_WOUT], DM, 1024, Wout_t, gd, gd, false, nullptr, scr, kb, lane); continue; } r -= I_OUT;
            if (r < I_UP) { const int kb = r / 128, gd = r % 128; p0_item(args.in[I_WUP], DM, FF, Wup_t, gd, gd, false, args.in[I_NMLP], scr, kb, lane); continue; } r -= I_UP;
            { const int kb = r / 32, gd = r % 32; p0_item(args.in[I_WDN], FF, 1024, Wdn_t, gd, gd, false, nullptr, scr, kb, lane); }
        }
        for (int idx = gw * 64 + lane; idx < SEQ * 16; idx += NGW * 64) { const int pos = idx >> 4, i = idx & 15;
            const float inv = powf(10000.0f, -(float)i / 16.0f), ang = (float)pos * inv; float s, c; sincosf(ang, &s, &c); ropetab[idx] = c; ropetab[65536 + idx] = s; }
        for (int m = gw; m < M; m += NGW) {
            const f32x4* xr = (const f32x4*)(args.in[I_X] + (size_t)m * DM) + lane; f32x4 v[4]; float s = 0.f;
#pragma unroll
            for (int j = 0; j < 4; ++j) { v[j] = xr[64 * j]; s += (v[j].x * v[j].x + v[j].y * v[j].y) + (v[j].z * v[j].z + v[j].w * v[j].w); }
            const float rstd = 1.0f / sqrtf(wave_sum(s) * (1.0f / DM) + EPS);
            unsigned long long* o8 = (unsigned long long*)(XB + (size_t)m * DM) + lane;
#pragma unroll
            for (int j = 0; j < 4; ++j) o8[64 * j] = (unsigned long long)pk2(v[j].x * rstd, v[j].y * rstd) | ((unsigned long long)pk2(v[j].z * rstd, v[j].w * rstd) << 32);
        }
    }
    SEAM(0);
    REPS(1) if (IN(1)) {
        pg8::Gemm g{XB, Win_t, M, N1, DM}; pg8::StaticOrder S; S.init(M, N1, G, bx);
        pg8::EpiInProj E{ws};
        pg8::gemm_phase<pg8::EpiInProj, pg8::StaticOrder, true, true>(lds, g, S, E);
    }
    SEAM(1);
    REPS(2) if (IN(2)) {
#ifndef NO_P2A
        { pg8::Gemm g{CQ, Wuq_t, M, 768, QL}; pg8::StaticOrder S; S.init(M, 768, G, bx); pg8::EpiQUp E{QB, ssq_q, ropetab};
          pg8::gemm_phase<pg8::EpiQUp, pg8::StaticOrder, true, true>(lds, g, S, E); }
#endif
#ifndef NO_P2B
        { pg8::Gemm g{CKV, Wukv_t, M, 1024, KVL}; pg8::StaticOrder S; S.init(M, 1024, G, bx); pg8::EpiKVUp E{KN, VB, ssq_kv};
          pg8::gemm_phase<pg8::EpiKVUp, pg8::StaticOrder, true, true>(lds, g, S, E); }
#endif
    }
    SEAM(2);
    REPS(3) if (IN(3)) {
        const att::AttnArgs A{QA, KA, VA, QB, KN, KR, VB, KMP, OA, OB, args.in[I_RELB]};
#ifdef EXP_COPY
        for (size_t i = (size_t)bx * 512 + tid; i < (size_t)M * 512 / 8; i += (size_t)G * 512) { ((v4u*)OA)[i] = ((const v4u*)VA)[i]; ((v4u*)OB)[i] = ((const v4u*)EXP_OBSRC)[i]; }
        if (0)
#endif
        for (int v = vcu; v < 256; v += G) { const int bh = v >> 2, s = v & 3, b = bh >> 3, h = bh & 7;
            for (int i = 0; i < 4; ++i) { const int n = (i == 0) ? 15 - s : (i == 1) ? 11 - s : (i == 2) ? 4 + s : s;
#ifndef EXP_NO_MLA
                att::attn_unit<1>(lds, A, b, h, n);
#endif
#ifndef EXP_NO_MOBA
                att::attn_unit<0>(lds, A, b, h, n);
#endif
            } }
    }
    SEAM(3);
    REPS(4) if (IN(4)) {
        { pg8::Gemm g{OA, Wpa_t, M, DM, AW}; pg8::StaticOrder S; S.init(M, DM, G, bx); pg8::EpiGate<false> E{MG, SGA}; pg8::gemm_phase<pg8::EpiGate<false>, pg8::StaticOrder, true, true>(lds, g, S, E); }
#ifndef EXP_P4_PASS1_ONLY
        { pg8::Gemm g{OB, Wpb_t, M, DM, AW}; pg8::StaticOrder S; S.init(M, DM, G, bx); pg8::EpiGate<true> E{MG, SGB}; pg8::gemm_phase<pg8::EpiGate<true>, pg8::StaticOrder, true, true>(lds, g, S, E); }
#endif
    }
    SEAM(4);
    REPS(5) if (IN(5)) {
        pg8::Gemm g{MG, Wout_t, M, DM, DM}; pg8::StaticOrder S; S.init(M, DM, G, bx); pg8::EpiResid E{args.in[I_X], args.out, HB, hs};
        pg8::gemm_phase<pg8::EpiResid, pg8::StaticOrder, true, true>(lds, g, S, E);
    }
    SEAM(5);
    REPS(6) if (IN(6)) {
        pg8::Gemm g{HB, Wup_t, M, FF, DM}; pg8::StaticOrder S; S.init(M, FF, G, bx); pg8::EpiUp E{U, hs};
        pg8::gemm_phase<pg8::EpiUp, pg8::StaticOrder, true, true>(lds, g, S, E);
    }
    SEAM(6);
    if (IN(7)) {
        pg8::Gemm g{U, Wdn_t, M, DM, FF}; pg8::StaticOrder S; S.init(M, DM, G, bx); pg8::EpiResid E{args.out, args.out, nullptr, h2s};
        pg8::gemm_phase<pg8::EpiResid, pg8::StaticOrder, true, true>(lds, g, S, E);
    }
    SEAM(7);
#ifdef EXP_DUMP_FULL
    if (IN(8)) { for (size_t i = (size_t)bx * 512 + tid; i < (size_t)M * 1024; i += (size_t)G * 512) args.out[i] = __uint_as_float((unsigned)EXP_DUMP_FULL[i] << 16); }
    if (0) {
#elif defined(EXP_DUMP1)
    if (IN(8)) {
        for (size_t i = (size_t)bx * 512 + tid; i < (size_t)M * 512; i += (size_t)G * 512) { const size_t row = i >> 9, c = i & 511;
            args.out[row * 1024 + c] = __uint_as_float((unsigned)EXP_DUMP_A[i] << 16); args.out[row * 1024 + 512 + c] = __uint_as_float((unsigned)EXP_DUMP_B[i] << 16); }
    }
    if (0) {
#else
    if (IN(8)) {
#endif
        const f32x4* gf = (const f32x4*)args.in[I_NFIN] + lane; f32x4 gv[4];
#pragma unroll
        for (int j = 0; j < 4; ++j) gv[j] = gf[64 * j];
        for (int m = gw; m < M; m += NGW) {
            const f32x4* sp = (const f32x4*)(h2s + (size_t)m * 16); const f32x4 t = (sp[0] + sp[1]) + (sp[2] + sp[3]);
            const float rstd = 1.0f / sqrtf(((t[0] + t[1]) + (t[2] + t[3])) * (1.0f / DM) + EPS);
            f32x4* xr = (f32x4*)(args.out + (size_t)m * DM) + lane;
#pragma unroll
            for (int j = 0; j < 4; ++j) xr[64 * j] = xr[64 * j] * rstd * gv[j];
        }
    }
#ifdef EXP_FENCE
    asm volatile("s_waitcnt vmcnt(0)" ::: "memory"); __builtin_amdgcn_fence(__ATOMIC_RELEASE, "agent"); asm volatile("s_waitcnt vmcnt(0)" ::: "memory");
#endif
#undef IN
#undef SEAM
}

extern "C" void kernel_launch(void* const* d_in, const int* in_sizes, int n_in, void* d_out, int out_size, void* d_ws, size_t ws_size, hipStream_t stream) {
    static int grid = 0;
    if (grid == 0) {
        if (n_in != 16 || in_sizes[0] != M * DM || out_size != M * DM || ws_size < WS_END) { fprintf(stderr, "kernel_launch: unexpected problem shape (n_in %d, ws %zu)\n", n_in, ws_size); grid = -1; return; }
        int dev = 0, cus = 0, per_cu = 0;
        if (hipGetDevice(&dev) != hipSuccess || hipDeviceGetAttribute(&cus, hipDeviceAttributeMultiprocessorCount, dev) != hipSuccess) { grid = -1; return; }
        if (hipFuncSetAttribute((const void*)mk_fwd, hipFuncAttributeMaxDynamicSharedMemorySize, LDS_BYTES) != hipSuccess) { fprintf(stderr, "kernel_launch: hipFuncSetAttribute failed\n"); grid = -1; return; }
        if (hipOccupancyMaxActiveBlocksPerMultiprocessor(&per_cu, (const void*)mk_fwd, NWAVES * 64, LDS_BYTES) != hipSuccess || per_cu < 1) { fprintf(stderr, "kernel_launch: occupancy query reports %d\n", per_cu); per_cu = 1; }
        (void)hipGetLastError();
        grid = cus;
    }
    if (grid < 0) return;
#ifdef DIAG_POISON
    (void)hipMemsetAsync(d_ws, 0xFF, WS_END, stream);
#endif
    if (hipMemsetAsync(d_ws, 0, 16384, stream) != hipSuccess) { fprintf(stderr, "kernel_launch: hipMemsetAsync failed\n"); return; }
    Args a{};
    for (int i = 0; i < 16; ++i) a.in[i] = (const float*)d_in[i];
    a.out = (float*)d_out; a.ws = (unsigned char*)d_ws;
    for (int li = 0; li < MK_N_LAUNCHES; ++li) {
#ifdef EXP_NO_MOBA
        if (li == 3) (void)hipMemsetAsync((char*)d_ws + WS_OA, 0, 32 * MiB, stream);
#endif
#ifdef EXP_NO_MLA
        if (li == 3) (void)hipMemsetAsync((char*)d_ws + WS_OB, 0, 32 * MiB, stream);
#endif
#ifdef EXP_SKIP_P2
        if (li == 2) continue;
#endif
#ifdef EXP_DUMP1
        if (li >= EXP_DUMP1 && li < 8) continue;
#endif
#ifdef EXP_SKIP_ATT
        if (li == 2) continue;
        if (li == 3) { (void)hipMemsetAsync((char*)d_ws + WS_OA, 0, 64 * MiB, stream); continue; }
#endif
        a.ph_lo = (MK_N_LAUNCHES == 1) ? 0 : li; a.ph_hi = (MK_N_LAUNCHES == 1) ? N_PHASES : li + 1;
        void* kargs[] = {&a};
        const hipError_t le = hipLaunchCooperativeKernel((const void*)mk_fwd, dim3(grid), dim3(NWAVES * 64), kargs, LDS_BYTES, stream);
        if (le != hipSuccess) { fprintf(stderr, "kernel_launch: launch %d failed: %s\n", li, hipGetErrorName(le)); break; }
    }
}
```
